# Optimizing an MI355X kernel written in HIP

```python
import math
import jax, jax.numpy as jnp
from jax import lax
import numpy as np

D_MODEL = 1024
BATCH = 4
SEQ = 4096
DEPTH = 4

SSM_WIDTH = D_MODEL // 2
SSM_GROUP = 16
SSM_GROUPS = SSM_WIDTH // SSM_GROUP
SSM_STATE = 64
HEAD_DIM = 64
NSA_WIDTH = D_MODEL // 2
N_HEADS = NSA_WIDTH // HEAD_DIM
N_KV = 2
Q_PER_KV = N_HEADS // N_KV
KV_WIDTH = N_KV * HEAD_DIM
CMP_LEN = 32
CMP_STRIDE = 16
CMP_HIDDEN = 128
SEL_BLOCK = 64
SEL_TOPK = 16
SEL_FORCED_SCORE = 1e4
WINDOW = 512
Q_BLOCK = 128
D_FF = 2816
ROPE_THETA = 10000.0
NORM_EPS = 1e-6
MASK_VALUE = -1e30
COL_SIZES = (SSM_WIDTH, NSA_WIDTH, KV_WIDTH, KV_WIDTH, KV_WIDTH, KV_WIDTH, KV_WIDTH, KV_WIDTH, 3 * N_HEADS, D_MODEL, D_MODEL)
IN_COLS = sum(COL_SIZES)
SPLIT_POINTS = tuple(int(v) for v in np.cumsum(COL_SIZES)[:-1])

kernel_name = 'hybrid_s5_nsa_macaron'


def rms_norm(x, gain):
    xf = x.astype(jnp.float32)
    y = xf * lax.rsqrt(jnp.mean(xf * xf, axis=-1, keepdims=True) + NORM_EPS)
    return (y * gain.astype(jnp.float32)).astype(x.dtype)


def rope(x, pos):
    half = x.shape[-1] // 2
    inv_freq = 1.0 / (ROPE_THETA ** (jnp.arange(half, dtype=jnp.float32) / half))
    ang = pos.astype(jnp.float32)[:, None] * inv_freq[None, :]
    cos = jnp.cos(ang)[:, None, :].astype(x.dtype)
    sin = jnp.sin(ang)[:, None, :].astype(x.dtype)
    x1, x2 = x[..., :half], x[..., half:]
    return jnp.concatenate([x1 * cos - x2 * sin, x2 * cos + x1 * sin], axis=-1)


def swiglu(h, wi, wo):
    gate, up = jnp.split(h @ wi, 2, axis=-1)
    return (jax.nn.silu(gate) * up) @ wo


def masked_softmax(scores, mask):
    s = jnp.where(mask, scores.astype(jnp.float32), MASK_VALUE)
    p = jax.nn.softmax(s, axis=-1)
    return p * jnp.any(mask, axis=-1, keepdims=True)


def complex_affine_combine(e1, e2):
    a1r, a1i, b1r, b1i = e1
    a2r, a2i, b2r, b2i = e2
    return (a1r * a2r - a1i * a2i,
            a1r * a2i + a1i * a2r,
            a2r * b1r - a2i * b1i + b2r,
            a2r * b1i + a2i * b1r + b2i)


def s5_branch(u, lam_re, lam_im, log_dt, b_re, b_im, c_re, c_im, d_skip, w_glu):
    bsz, seq, _ = u.shape
    u_g = u.reshape(bsz, seq, SSM_GROUPS, SSM_GROUP).astype(jnp.float32)
    dt = jnp.exp(log_dt.astype(jnp.float32))[:, None]
    lr = lam_re.astype(jnp.float32)
    li = lam_im.astype(jnp.float32)
    mag = jnp.exp(lr * dt)
    ang = li * dt
    abar_re, abar_im = mag * jnp.cos(ang), mag * jnp.sin(ang)
    inv_abs2 = 1.0 / (lr * lr + li * li)
    num_re, num_im = abar_re - 1.0, abar_im
    f_re = (num_re * lr + num_im * li) * inv_abs2
    f_im = (num_im * lr - num_re * li) * inv_abs2
    br, bi = b_re.astype(jnp.float32), b_im.astype(jnp.float32)
    bbar_re = f_re[..., None] * br - f_im[..., None] * bi
    bbar_im = f_re[..., None] * bi + f_im[..., None] * br
    bu_re = jnp.einsum('bsgc,gnc->bsgn', u_g, bbar_re)
    bu_im = jnp.einsum('bsgc,gnc->bsgn', u_g, bbar_im)
    a_re = jnp.broadcast_to(abar_re, (1, seq, SSM_GROUPS, SSM_STATE))
    a_im = jnp.broadcast_to(abar_im, (1, seq, SSM_GROUPS, SSM_STATE))
    _, _, st_re, st_im = lax.associative_scan(complex_affine_combine, (a_re, a_im, bu_re, bu_im), axis=1)
    y = (jnp.einsum('bsgn,gcn->bsgc', st_re, c_re.astype(jnp.float32))
         - jnp.einsum('bsgn,gcn->bsgc', st_im, c_im.astype(jnp.float32))
         + d_skip.astype(jnp.float32) * u_g)
    y = jax.nn.gelu(y.reshape(bsz, seq, SSM_WIDTH)).astype(u.dtype)
    val, gate = jnp.split(y @ w_glu, 2, axis=-1)
    return val * jax.nn.sigmoid(gate)


def compress(kv, pe, w1, w2):
    bsz, seq = kv.shape[0], kv.shape[1]
    n_cmp = (seq - CMP_LEN) // CMP_STRIDE + 1
    idx = np.arange(n_cmp)[:, None] * CMP_STRIDE + np.arange(CMP_LEN)[None, :]
    blocks = kv[:, idx] + pe[:, None, :]
    blocks = jnp.moveaxis(blocks, 2, 3).reshape(bsz, n_cmp, N_KV, CMP_LEN * HEAD_DIM)
    return jax.nn.gelu(blocks @ w1) @ w2


def selection_overlap(n_cmp, n_sel):
    cs = np.arange(n_cmp)[:, None] * CMP_STRIDE
    ss = np.arange(n_sel)[None, :] * SEL_BLOCK
    inter = np.clip(np.minimum(cs + CMP_LEN, ss + SEL_BLOCK) - np.maximum(cs, ss), 0, None)
    return jnp.asarray(inter / CMP_LEN, dtype=jnp.float32)


def nsa_branch(q_raw, k_cmp, v_cmp, k_sel, v_sel, k_win, v_win, gate_logits,
               q_norm, k_norm, cmp_pe, cmp_w1, cmp_w2):
    bsz, seq = q_raw.shape[0], q_raw.shape[1]
    pos = jnp.arange(seq, dtype=jnp.int32)
    heads = lambda a: a.reshape(bsz, seq, N_KV, HEAD_DIM)
    q = rope(rms_norm(q_raw.reshape(bsz, seq, N_HEADS, HEAD_DIM), q_norm), pos)
    q = q.reshape(bsz, seq, N_KV, Q_PER_KV, HEAD_DIM)
    n_cmp = (seq - CMP_LEN) // CMP_STRIDE + 1
    cmp_end = jnp.arange(n_cmp, dtype=jnp.int32) * CMP_STRIDE + (CMP_LEN - 1)
    k_c = compress(heads(k_cmp), cmp_pe[0], cmp_w1[0], cmp_w2[0])
    v_c = compress(heads(v_cmp), cmp_pe[1], cmp_w1[1], cmp_w2[1])
    k_c = rope(rms_norm(k_c, k_norm[0]), cmp_end)
    n_sel = seq // SEL_BLOCK
    top_k = min(SEL_TOPK, n_sel)
    overlap = selection_overlap(n_cmp, n_sel)
    to_sel = lambda a: jnp.moveaxis(a.reshape(bsz, n_sel, SEL_BLOCK, N_KV, HEAD_DIM), 3, 1)
    ks_blocks = to_sel(rope(rms_norm(heads(k_sel), k_norm[1]), pos))
    vs_blocks = to_sel(heads(v_sel))
    pad = lambda a: jnp.pad(a, ((0, 0), (WINDOW, 0), (0, 0), (0, 0)))
    kw_pad = pad(rope(rms_norm(heads(k_win), k_norm[2]), pos))
    vw_pad = pad(heads(v_win))
    gates = jax.nn.sigmoid(gate_logits.astype(jnp.float32)).reshape(bsz, seq, N_KV, Q_PER_KV, 3).astype(q.dtype)
    scale = HEAD_DIM ** -0.5
    gather_blocks = jax.vmap(jax.vmap(lambda blocks, ix: blocks[ix]))
    n_qb = seq // Q_BLOCK
    to_qb = lambda a: jnp.moveaxis(a.reshape(bsz, n_qb, Q_BLOCK, *a.shape[2:]), 1, 0)
    sel_j = jnp.arange(n_sel, dtype=jnp.int32)

    def block_fn(args):
        qb, gb, blk = args
        qs = blk * Q_BLOCK
        t = qs + jnp.arange(Q_BLOCK, dtype=jnp.int32)
        s_c = jnp.einsum('bqgrd,bngd->bgrqn', qb, k_c) * scale
        p_c = masked_softmax(s_c, cmp_end[None, :] <= t[:, None])
        o_c = jnp.einsum('bgrqn,bngd->bqgrd', p_c.astype(v_c.dtype), v_c)
        imp = jnp.einsum('bgrqn,nj->bgqj', p_c, overlap)
        cur = t // SEL_BLOCK
        valid = sel_j[None, :] <= cur[:, None]
        forced = (sel_j[None, :] == 0) | (sel_j[None, :] == cur[:, None]) | (sel_j[None, :] == cur[:, None] - 1)
        prio = jnp.where(valid, jnp.where(forced, SEL_FORCED_SCORE, imp), -1.0)
        _, idx = lax.top_k(prio, top_k)
        n_tok = top_k * SEL_BLOCK
        k_g = gather_blocks(ks_blocks, idx).reshape(bsz, N_KV, Q_BLOCK, n_tok, HEAD_DIM)
        v_g = gather_blocks(vs_blocks, idx).reshape(bsz, N_KV, Q_BLOCK, n_tok, HEAD_DIM)
        tok = (idx[..., None] * SEL_BLOCK + jnp.arange(SEL_BLOCK, dtype=jnp.int32)).reshape(bsz, N_KV, Q_BLOCK, n_tok)
        s_s = jnp.einsum('bqgrd,bgqld->bgrql', qb, k_g) * scale
        p_s = masked_softmax(s_s, (tok <= t[None, None, :, None])[:, :, None])
        o_s = jnp.einsum('bgrql,bgqld->bqgrd', p_s.astype(v_g.dtype), v_g)
        k_wb = lax.dynamic_slice_in_dim(kw_pad, qs, WINDOW + Q_BLOCK, axis=1)
        v_wb = lax.dynamic_slice_in_dim(vw_pad, qs, WINDOW + Q_BLOCK, axis=1)
        kpos = qs - WINDOW + jnp.arange(WINDOW + Q_BLOCK, dtype=jnp.int32)
        diff = t[:, None] - kpos[None, :]
        mask_w = (kpos[None, :] >= 0) & (diff >= 0) & (diff < WINDOW)
        s_w = jnp.einsum('bqgrd,bkgd->bgrqk', qb, k_wb) * scale
        p_w = masked_softmax(s_w, mask_w)
        o_w = jnp.einsum('bgrqk,bkgd->bqgrd', p_w.astype(v_wb.dtype), v_wb)
        return gb[..., 0:1] * o_c + gb[..., 1:2] * o_s + gb[..., 2:3] * o_w

    out = lax.map(block_fn, (to_qb(q), to_qb(gates), jnp.arange(n_qb, dtype=jnp.int32)))
    return jnp.moveaxis(out, 0, 1).reshape(bsz, seq, NSA_WIDTH)


def setup_inputs(seed: int = 0) -> dict:
    key = jax.random.key(seed)
    ks = jax.random.split(key, 32)
    nrm = lambda k, shape, s: jax.random.normal(k, shape, jnp.float32) * s
    L, D, G, N, C = DEPTH, D_MODEL, SSM_GROUPS, SSM_STATE, SSM_GROUP
    return {
        'x': nrm(ks[0], (BATCH, SEQ, D), 1.0),
        'norm_ffn1': 1.0 + nrm(ks[1], (L, D), 0.02),
        'ffn1_wi': nrm(ks[2], (L, D, 2 * D_FF), D ** -0.5),
        'ffn1_wo': nrm(ks[3], (L, D_FF, D), D_FF ** -0.5),
        'norm_mix': 1.0 + nrm(ks[4], (L, D), 0.02),
        'w_in': nrm(ks[5], (L, D, IN_COLS), D ** -0.5),
        'ssm_lambda_re': -0.5 + nrm(ks[6], (L, G, N), 0.01),
        'ssm_lambda_im': math.pi * jnp.arange(N, dtype=jnp.float32) + nrm(ks[7], (L, G, N), 0.01),
        'ssm_log_dt': jax.random.uniform(ks[8], (L, G), jnp.float32, math.log(1e-3), math.log(1e-1)),
        'ssm_b_re': nrm(ks[9], (L, G, N, C), (2 * C) ** -0.5),
        'ssm_b_im': nrm(ks[10], (L, G, N, C), (2 * C) ** -0.5),
        'ssm_c_re': nrm(ks[11], (L, G, C, N), N ** -0.5),
        'ssm_c_im': nrm(ks[12], (L, G, C, N), N ** -0.5),
        'ssm_d': nrm(ks[13], (L, G, C), 1.0),
        'ssm_w_glu': nrm(ks[14], (L, SSM_WIDTH, 2 * D), SSM_WIDTH ** -0.5),
        'q_norm': 1.0 + nrm(ks[15], (L, HEAD_DIM), 0.02),
        'k_norm': 1.0 + nrm(ks[16], (L, 3, HEAD_DIM), 0.02),
        'cmp_pe': nrm(ks[17], (L, 2, CMP_LEN, HEAD_DIM), 0.1),
        'cmp_w1': nrm(ks[18], (L, 2, CMP_LEN * HEAD_DIM, CMP_HIDDEN), (CMP_LEN * HEAD_DIM) ** -0.5),
        'cmp_w2': nrm(ks[19], (L, 2, CMP_HIDDEN, HEAD_DIM), CMP_HIDDEN ** -0.5),
        'nsa_w_up': nrm(ks[20], (L, NSA_WIDTH, D), NSA_WIDTH ** -0.5),
        'w_out': nrm(ks[21], (L, D, D), D ** -0.5),
        'norm_ffn2': 1.0 + nrm(ks[22], (L, D), 0.02),
        'ffn2_wi': nrm(ks[23], (L, D, 2 * D_FF), D ** -0.5),
        'ffn2_wo': nrm(ks[24], (L, D_FF, D), D_FF ** -0.5),
    }


def reference(x, norm_ffn1, ffn1_wi, ffn1_wo, norm_mix, w_in,
              ssm_lambda_re, ssm_lambda_im, ssm_log_dt, ssm_b_re, ssm_b_im,
              ssm_c_re, ssm_c_im, ssm_d, ssm_w_glu,
              q_norm, k_norm, cmp_pe, cmp_w1, cmp_w2, nsa_w_up, w_out,
              norm_ffn2, ffn2_wi, ffn2_wo):
    for l in range(DEPTH):
        x = x + 0.5 * swiglu(rms_norm(x, norm_ffn1[l]), ffn1_wi[l], ffn1_wo[l])
        h = rms_norm(x, norm_mix[l])
        (u, q_raw, k_cmp, v_cmp, k_sel, v_sel, k_win, v_win,
         nsa_gate, gate_a, gate_b) = jnp.split(h @ w_in[l], SPLIT_POINTS, axis=-1)
        y_a = s5_branch(u, ssm_lambda_re[l], ssm_lambda_im[l], ssm_log_dt[l],
                        ssm_b_re[l], ssm_b_im[l], ssm_c_re[l], ssm_c_im[l],
                        ssm_d[l], ssm_w_glu[l])
        y_b = nsa_branch(q_raw, k_cmp, v_cmp, k_sel, v_sel, k_win, v_win, nsa_gate,
                         q_norm[l], k_norm[l], cmp_pe[l], cmp_w1[l], cmp_w2[l]) @ nsa_w_up[l]
        merged = jax.nn.sigmoid(gate_a) * y_a + jax.nn.sigmoid(gate_b) * y_b
        x = x + merged @ w_out[l]
        x = x + 0.5 * swiglu(rms_norm(x, norm_ffn2[l]), ffn2_wi[l], ffn2_wo[l])
    return x
```

```cpp
#include <hip/hip_runtime.h>
#include <hip/hip_cooperative_groups.h>
#include <cstdio>
namespace cg = cooperative_groups;

#ifndef REP_MASK
#define REP_MASK 0
#endif
#ifndef MULTI_LAUNCH
#define MULTI_LAUNCH 0
#endif

#define LAS __attribute__((address_space(3)))
typedef unsigned short bf16_t;
typedef short bf16x8 __attribute__((ext_vector_type(8)));
typedef short s16x4 __attribute__((ext_vector_type(4)));
typedef float f32x4 __attribute__((ext_vector_type(4)));
typedef float f32x2 __attribute__((ext_vector_type(2)));
typedef unsigned u32x4 __attribute__((ext_vector_type(4)));
typedef unsigned u32x2 __attribute__((ext_vector_type(2)));

constexpr int NTOK = 16384, DM = 1024, DFF = 2816, SEQ = 4096, NLAYER = 4;
constexpr int LDS_STAGE = 131072, LDS_WORK = 136192, LDS_BYTES = LDS_WORK + 16;
constexpr float EPS = 1e-6f;
constexpr float QSCALE = 0.125f * 1.4426950408889634f;

constexpr size_t SZ_WI = 5632ull * 1024 * 2, SZ_WO = 1024ull * 2816 * 2;
constexpr size_t OFF_WI1 = 0;
constexpr size_t OFF_WO1 = OFF_WI1 + SZ_WI;
constexpr size_t OFF_WI2 = OFF_WO1 + SZ_WO;
constexpr size_t OFF_WO2 = OFF_WI2 + SZ_WI;
constexpr size_t OFF_WIN = OFF_WO2 + SZ_WO;
constexpr size_t OFF_WGLU = OFF_WIN + 4096ull * 1024 * 2;
constexpr size_t OFF_WUP = OFF_WGLU + 2048ull * 512 * 2;
constexpr size_t OFF_WOUT = OFF_WUP + 1024ull * 512 * 2;
constexpr size_t OFF_CW1 = OFF_WOUT + 1024ull * 1024 * 2;
constexpr size_t OFF_CBIAS = OFF_CW1 + 2ull * 256 * 2048 * 2;
constexpr size_t OFF_POW = OFF_CBIAS + 4096;
constexpr size_t OFF_BBAR = OFF_POW + 4ull * 32 * 64 * 34 * 8;
constexpr size_t OFF_KG = OFF_BBAR + 4ull * 32 * 64 * 16 * 8;
constexpr size_t OFF_PT = OFF_KG + 4ull * 32 * 32 * 256 * 4;
constexpr size_t OFF_TQ = OFF_PT + 4ull * 32 * 128 * 512 * 2 + 128ull * 512 * 2;
constexpr size_t OFF_ROPE = OFF_TQ + 4ull * 32 * 512 * 640 * 2;
constexpr size_t OFF_XB = OFF_ROPE + 4096ull * 32 * 8;
constexpr size_t OFF_PART = OFF_XB + 16384ull * 1024 * 2;
constexpr size_t OFF_MIX = OFF_PART + 16384ull * 16 * 4;
constexpr size_t OFF_G = OFF_MIX;
constexpr size_t OFF_AG = OFF_MIX;
constexpr size_t OFF_NSA = OFF_AG;
constexpr size_t OFF_QN = OFF_AG + 32ull * 512 * 640 * 2;
constexpr size_t SZ_KV = 8ull * 4096 * 64 * 2;
constexpr size_t OFF_KCR = OFF_QN + 16384ull * 512 * 2;
constexpr size_t OFF_VCR = OFF_KCR + SZ_KV + 2048;
constexpr size_t OFF_KSEL = OFF_VCR + SZ_KV + 2048;
constexpr size_t OFF_VSELT = OFF_KSEL + SZ_KV;
constexpr size_t OFF_KWIN = OFF_VSELT + SZ_KV;
constexpr size_t OFF_VWINT = OFF_KWIN + SZ_KV;
constexpr size_t OFF_KCN = OFF_VWINT + SZ_KV;
constexpr size_t OFF_VCT = OFF_KCN + 8ull * 256 * 64 * 2;
constexpr size_t OFF_GA = OFF_VCT + 8ull * 256 * 64 * 2;
constexpr size_t OFF_GB = OFF_GA + 16384ull * 1024 * 2;
constexpr size_t OFF_NGATE = OFF_GB + 16384ull * 1024 * 2;
constexpr size_t OFF_Y = OFF_NGATE + 16384ull * 24 * 4;
constexpr size_t OFF_CPART = OFF_Y;
constexpr size_t OFF_OC = OFF_Y + 16384ull * 512 * 2;
constexpr size_t OFF_E = OFF_OC;
constexpr size_t OFF_SELM = OFF_OC + 16384ull * 512 * 2;
constexpr size_t OFF_BAR = OFF_SELM + 8ull * 4096 * 8;
constexpr size_t OFF_WALT = OFF_BAR + 16384;
constexpr size_t WS_END = OFF_WALT + OFF_CBIAS;
static_assert(OFF_G + 16384ull * 2816 * 2 <= WS_END, "G alias");
static_assert(2ull * 8 * 2048 * 128 * 4 <= 16384ull * 512 * 2, "cpart alias");

struct Params {
    const float *x, *norm_ffn1, *ffn1_wi, *ffn1_wo, *norm_mix, *w_in, *lam_re, *lam_im, *log_dt, *b_re, *b_im, *c_re, *c_im, *ssm_d, *w_glu,
        *q_norm, *k_norm, *cmp_pe, *cmp_w1, *cmp_w2, *w_up, *w_out, *norm_ffn2, *ffn2_wi, *ffn2_wo;
    float* out;
    unsigned char* ws;
    int ph0, ph1;
};

__device__ __forceinline__ int opaque_tid() { int t = threadIdx.x; asm volatile("" : "+v"(t)); return t; }
__device__ __forceinline__ int opaque_bid() { int t = blockIdx.x; asm volatile("" : "+s"(t)); return t; }
typedef __bf16 bf16x2_t __attribute__((ext_vector_type(2)));
__device__ __forceinline__ unsigned cvt_pk_bf16(float lo, float hi) { bf16x2_t v; v.x = (__bf16)lo; v.y = (__bf16)hi; return __builtin_bit_cast(unsigned, v); }
typedef _Float16 f16x2 __attribute__((ext_vector_type(2)));
typedef _Float16 f16x8 __attribute__((ext_vector_type(8)));
__device__ __forceinline__ unsigned cvt_pk_f16(float lo, float hi) { f16x2 v; v.x = (_Float16)lo; v.y = (_Float16)hi; return __builtin_bit_cast(unsigned, v); }
__device__ __forceinline__ f32x2 unpk_f16(unsigned w) { const f16x2 v = __builtin_bit_cast(f16x2, w); return (f32x2){(float)v.x, (float)v.y}; }
__device__ __forceinline__ bf16_t f2bf(float f) { return (bf16_t)(cvt_pk_bf16(f, 0.f) & 0xffffu); }
__device__ __forceinline__ float fexp2(float x) { return __builtin_amdgcn_exp2f(x); }
__device__ __forceinline__ float sigmoidf_(float x) { return __builtin_amdgcn_rcpf(1.0f + __builtin_amdgcn_exp2f(-1.4426950408889634f * x)); }
__device__ __forceinline__ float gelu_tanh(float x) { const float u = 0.7978845608028654f * (x + 0.044715f * x * x * x); return x * __builtin_amdgcn_rcpf(1.0f + __builtin_amdgcn_exp2f(-2.0f * 1.4426950408889634f * u)); }
__device__ __forceinline__ u32x4 pack8(const float (&o)[8]) { u32x4 w; w.x = cvt_pk_bf16(o[0], o[1]); w.y = cvt_pk_bf16(o[2], o[3]); w.z = cvt_pk_bf16(o[4], o[5]); w.w = cvt_pk_bf16(o[6], o[7]); return w; }
__device__ __forceinline__ float rowscale(const float* part, int row) {
    const f32x4* p = (const f32x4*)(part + (size_t)row * 16);
    const f32x4 a = p[0], b = p[1], c = p[2], d = p[3];
    const float s = ((a[0] + a[1]) + (a[2] + a[3])) + ((b[0] + b[1]) + (b[2] + b[3])) + ((c[0] + c[1]) + (c[2] + c[3])) + ((d[0] + d[1]) + (d[2] + d[3]));
    return rsqrtf(s * (1.0f / 1024.0f) + EPS);
}

__device__ __forceinline__ float rowscale4(const float* part, int row, int fq) {
    const f32x4 a = *(const f32x4*)(part + (size_t)row * 16 + 4 * fq);
    float s = (a[0] + a[1]) + (a[2] + a[3]); s += __shfl_xor(s, 16); s += __shfl_xor(s, 32);
    return rsqrtf(s * (1.0f / 1024.0f) + EPS);
}

__device__ __forceinline__ int win_role(int pn) { return pn == 4 ? 6 : (pn == 6 ? 4 : pn); }

namespace pg8 {
constexpr int BM = 256, BK = 64, HALF = 128, HTB = HALF * BK * 2, NXCD = 8, WGM = 8;
constexpr int AGS = 16384 * 16;
__device__ __forceinline__ int lds_byte(int r, int c) { const int st = (r >> 4) * 2 + (c >> 5), rr = r & 15, cc = c & 31, ob = rr * 64 + cc * 2; return st * 1024 + (ob ^ (((ob >> 9) & 1) << 5)); }
__device__ __forceinline__ void stage_rc(int b, int& R, int& C) { const int st = b / 1024, sb = b % 1024, swz = sb ^ (((sb >> 9) & 1) << 5); R = (st >> 1) * 16 + swz / 64; C = (st & 1) * 32 + (swz % 64) / 2; }
__device__ __forceinline__ int perm32(int rho) { const int n = rho >> 4, i = rho & 15; return 8 * (i >> 2) + 4 * n + (i & 3); }

struct Unit { int pm, pn, z; };
struct Gemm { const bf16_t* A; const bf16_t* Bt; int lda, ldb, K, nM, nN, nZ, nZ2; long sA1, sA2, sB1, sB2; };
struct Sched {
    int nM, nN, nwg, tot, G, c;
    __device__ __forceinline__ void init(const Gemm& g, int G_, int c_) { nM = g.nM; nN = g.nN; nwg = nM * nN; tot = nwg * g.nZ; G = G_; c = c_; }
    __device__ __forceinline__ bool next(int i, Unit& u) const {
        const long L = (long)i * G + c; if (c < 0 || L >= tot) return false;
        u.z = (int)(L / nwg); int wgid = (int)(L % nwg);
        { const int q = nwg / NXCD, r = nwg % NXCD, xcd = wgid % NXCD, off = wgid / NXCD; wgid = (xcd < r ? xcd * (q + 1) : r * (q + 1) + (xcd - r) * q) + off; }
        const int nig = WGM * nN, gid = wgid / nig, fm = gid * WGM, gsz = (nM - fm) < WGM ? (nM - fm) : WGM;
        u.pm = fm + ((wgid % nig) % gsz); u.pn = (wgid % nig) / gsz; return true;
    }
};

template <class Epi>
__device__ __forceinline__ void gemm_phase(LAS unsigned char* lds, const Gemm g, const Sched& S, const Epi& E) {
    const int tid = opaque_tid(), wid = __builtin_amdgcn_readfirstlane(tid >> 6), lane = tid & 63, wr = wid >> 2, wc = wid & 3, fr = lane & 15, fq = lane >> 4;
    const int K = g.K, nt = K / BK;
    unsigned voffA[2], voffB[2];
#pragma unroll
    for (int i = 0; i < 2; ++i) { int R, C; stage_rc(tid * 16 + i * 8192, R, C); const int Rb = Epi::PERM ? ((R & ~31) + perm32(R & 31)) : R;
        voffA[i] = Epi::AGROUP ? (unsigned)((C >> 4) * AGS + R * 16 + (C & 15)) * 2u : (unsigned)(R * g.lda + C) * 2u; voffB[i] = (unsigned)(Rb * g.ldb + C) * 2u; }
    const size_t kstep = (size_t)(BK * 2);
    const size_t kstepA = Epi::AGROUP ? (size_t)(BK / 16) * AGS * 2 : kstep;
    const size_t hstepA = Epi::AGROUP ? (size_t)HALF * 16 * 2 : (size_t)HALF * g.lda * 2, hstepB = (size_t)HALF * g.ldb * 2;
    const unsigned ldsw = (unsigned)wid * 1024u;
    const int aoff = lds_byte(wr * 64 + fr, fq * 8), boff = lds_byte(wc * 32 + fr, fq * 8);
#define PG8_SA(b, h) (((b) * 2 + (h)) * HTB)
#define PG8_SB(b, h) ((4 + (b) * 2 + (h)) * HTB)
#define PG8_STAGE(bufoff, gbase, voff) do { _Pragma("unroll") for (int _i = 0; _i < 2; ++_i) \
        __builtin_amdgcn_global_load_lds((const unsigned*)((const char*)(gbase) + (voff)[_i]), (LAS unsigned*)(lds + (bufoff) + ldsw + _i * 8192), 16, 0, 0); } while (0)
#define PG8_LDA(dst, b, h) do { _Pragma("unroll") for (int m = 0; m < 4; ++m) _Pragma("unroll") for (int k = 0; k < 2; ++k) dst[m][k] = *(const LAS bf16x8*)(lds + PG8_SA(b, h) + aoff + m * 2048 + k * 1024); } while (0)
#define PG8_LDB(dst, b, h) do { _Pragma("unroll") for (int n = 0; n < 2; ++n) _Pragma("unroll") for (int k = 0; k < 2; ++k) dst[n][k] = *(const LAS bf16x8*)(lds + PG8_SB(b, h) + boff + n * 2048 + k * 1024); } while (0)
#define PG8_MMA(ai, bj, At, Bt) do { __builtin_amdgcn_s_setprio(1); _Pragma("unroll") for (int m = 0; m < 4; ++m) _Pragma("unroll") for (int n = 0; n < 2; ++n) _Pragma("unroll") for (int k = 0; k < 2; ++k) \
        { if constexpr (Epi::F16) acc[ai][bj][m][n] = __builtin_amdgcn_mfma_f32_16x16x32_f16(__builtin_bit_cast(f16x8, Bt[n][k]), __builtin_bit_cast(f16x8, At[m][k]), acc[ai][bj][m][n], 0, 0, 0); \
          else acc[ai][bj][m][n] = __builtin_amdgcn_mfma_f32_16x16x32_bf16(Bt[n][k], At[m][k], acc[ai][bj][m][n], 0, 0, 0); } __builtin_amdgcn_s_setprio(0); } while (0)
#define PG8_WAIT_V(n) asm volatile("s_waitcnt vmcnt(" #n ")" ::: "memory")
#define PG8_WAIT_L(n) asm volatile("s_waitcnt lgkmcnt(" #n ")" ::: "memory")
#define PG8_BAR __builtin_amdgcn_s_barrier()
#define PG8_SCHED __builtin_amdgcn_sched_barrier(0)
#define PG8_ABASE(u) ((const char*)g.A + ((size_t)((u).z / g.nZ2) * g.sA1 + (size_t)((u).z % g.nZ2) * g.sA2 + (size_t)(u).pm * 256 * (Epi::AGROUP ? 16 : g.lda)) * 2)
#define PG8_BBASE(u) ((const char*)g.Bt + ((size_t)((u).z / g.nZ2) * g.sB1 + (size_t)((u).z % g.nZ2) * g.sB2 + (size_t)(u).pn * 256 * g.ldb) * 2)
    Unit cur, nxt; int ui = 0;
    if (!S.next(0, cur)) return;
    f32x4 acc[2][2][4][2];
#pragma unroll
    for (int a = 0; a < 2; ++a)
#pragma unroll
        for (int b = 0; b < 2; ++b)
#pragma unroll
            for (int m = 0; m < 4; ++m)
#pragma unroll
                for (int n = 0; n < 2; ++n) acc[a][b][m][n] = (f32x4){0.f, 0.f, 0.f, 0.f};
    bf16x8 At[4][2], B0[2][2], B1[2][2];
    const char* cA = PG8_ABASE(cur); const char* cB = PG8_BBASE(cur);
    PG8_STAGE(PG8_SB(0, 0), cB, voffB); PG8_STAGE(PG8_SA(0, 0), cA, voffA); PG8_STAGE(PG8_SB(0, 1), cB + hstepB, voffB); PG8_STAGE(PG8_SA(0, 1), cA + hstepA, voffA);
    if (wr == 1) PG8_BAR;
    PG8_WAIT_V(4); PG8_BAR;
    PG8_STAGE(PG8_SB(1, 0), cB + kstep, voffB); PG8_STAGE(PG8_SA(1, 0), cA + kstepA, voffA); PG8_STAGE(PG8_SB(1, 1), cB + hstepB + kstep, voffB);
    PG8_WAIT_V(6); PG8_BAR;
    for (;;) {
        const bool has_next = S.next(ui + 1, nxt);
        const char* nA = has_next ? PG8_ABASE(nxt) : cA; const char* nB = has_next ? PG8_BBASE(nxt) : cB;
        for (int t = 0; t < nt; t += 2) {
            const bool last = (t == nt - 2);
            const char* a1 = cA + (size_t)(t + 1) * kstepA;
            const char* a2 = last ? nA : cA + (size_t)(t + 2) * kstepA; const char* b2 = last ? nB : cB + (size_t)(t + 2) * kstep;
            const char* a3 = a2 + kstepA; const char* b3 = b2 + kstep;
            PG8_LDB(B0, 0, 0); PG8_SCHED; PG8_LDA(At, 0, 0); PG8_STAGE(PG8_SA(1, 1), a1 + hstepA, voffA);
            PG8_WAIT_L(8); PG8_BAR; PG8_WAIT_L(0); PG8_MMA(0, 0, At, B0); PG8_BAR; PG8_SCHED;
            PG8_LDB(B1, 0, 1); PG8_STAGE(PG8_SB(0, 0), b2, voffB);
            PG8_BAR; PG8_WAIT_L(0); PG8_MMA(0, 1, At, B1); PG8_BAR;
            PG8_LDA(At, 0, 1); PG8_STAGE(PG8_SA(0, 0), a2, voffA);
            PG8_BAR; PG8_WAIT_L(0); PG8_MMA(1, 0, At, B0); PG8_BAR; PG8_SCHED;
            PG8_STAGE(PG8_SB(0, 1), b2 + hstepB, voffB);
            PG8_WAIT_V(6); PG8_BAR; PG8_MMA(1, 1, At, B1); PG8_BAR;
            PG8_LDB(B0, 1, 0); PG8_SCHED; PG8_LDA(At, 1, 0); PG8_STAGE(PG8_SA(0, 1), a2 + hstepA, voffA);
            PG8_WAIT_L(8); PG8_BAR; PG8_WAIT_L(0); PG8_MMA(0, 0, At, B0); PG8_BAR; PG8_SCHED;
            PG8_LDB(B1, 1, 1); PG8_STAGE(PG8_SB(1, 0), b3, voffB);
            PG8_BAR; PG8_WAIT_L(0); PG8_MMA(0, 1, At, B1); PG8_BAR;
            PG8_LDA(At, 1, 1); PG8_STAGE(PG8_SA(1, 0), a3, voffA);
            PG8_BAR; PG8_WAIT_L(0); PG8_MMA(1, 0, At, B0); PG8_BAR; PG8_SCHED;
            PG8_STAGE(PG8_SB(1, 1), b3 + hstepB, voffB);
            PG8_WAIT_V(6); PG8_BAR; PG8_MMA(1, 1, At, B1); PG8_BAR;
        }
        { int efr = fr, efq = fq, ewr = wr, ewc = wc; asm volatile("" : "+v"(efr), "+v"(efq), "+s"(ewr), "+s"(ewc));
          E(acc, cur, ewr, ewc, efr, efq); }
        if (!has_next) break;
#pragma unroll
        for (int a = 0; a < 2; ++a)
#pragma unroll
            for (int b = 0; b < 2; ++b)
#pragma unroll
                for (int m = 0; m < 4; ++m)
#pragma unroll
                    for (int n = 0; n < 2; ++n) acc[a][b][m][n] = (f32x4){0.f, 0.f, 0.f, 0.f};
        cur = nxt; cA = nA; cB = nB; ++ui;
    }
    PG8_WAIT_V(0);
    if (wr == 0) PG8_BAR;
    PG8_BAR;
#undef PG8_SA
#undef PG8_SB
#undef PG8_STAGE
#undef PG8_LDA
#undef PG8_LDB
#undef PG8_MMA
#undef PG8_WAIT_V
#undef PG8_WAIT_L
#undef PG8_BAR
#undef PG8_SCHED
#undef PG8_ABASE
#undef PG8_BBASE
}
}
using pg8::Unit; using pg8::Gemm; using pg8::Sched;
typedef const f32x4 (&AccRef)[2][2][4][2];

struct EpiFFNup {
    static constexpr bool AGROUP = false;
    static constexpr bool F16 = true;
    static constexpr bool PERM = true; const float* part; bf16_t* G;
    __device__ __forceinline__ void operator()(AccRef acc, const Unit& u, int wr, int wc, int fr, int fq) const {
        const int row0 = u.pm * 256 + wr * 64 + fr, col0 = u.pn * 128 + wc * 32 + 8 * fq;
#pragma unroll
        for (int ai = 0; ai < 2; ++ai)
#pragma unroll
            for (int m = 0; m < 4; ++m) { const int row = row0 + ai * 128 + m * 16; const float rs = rowscale4(part, row, fq); float o[8];
#pragma unroll
                for (int n = 0; n < 2; ++n)
#pragma unroll
                    for (int j = 0; j < 4; ++j) { const float gt = acc[ai][0][m][n][j] * rs, up = acc[ai][1][m][n][j] * rs; o[4 * n + j] = gt * sigmoidf_(gt) * up; }
                *(u32x4*)(G + (size_t)row * DFF + col0) = pack8(o); }
    }
};
struct EpiResid {
    static constexpr bool AGROUP = false;
    static constexpr bool F16 = false;
    static constexpr bool PERM = false; float* out; bf16_t* xb; float* part; float alpha;
    __device__ __forceinline__ void operator()(AccRef acc, const Unit& u, int wr, int wc, int fr, int fq) const {
        const int row0 = u.pm * 256 + wr * 64 + fr, col0 = u.pn * 256 + wc * 32 + 4 * fq;
        const bf16_t* __restrict__ xin = xb; bf16_t* __restrict__ xo_ = xb;
#pragma unroll
        for (int ai = 0; ai < 2; ++ai) {
            u32x2 xv0[4][2][2];
#pragma unroll
            for (int m = 0; m < 4; ++m)
#pragma unroll
                for (int bj = 0; bj < 2; ++bj)
#pragma unroll
                    for (int n = 0; n < 2; ++n) xv0[m][bj][n] = *(const u32x2*)(xin + (size_t)(row0 + ai * 128 + m * 16) * DM + col0 + bj * 128 + n * 16);
#pragma unroll
            for (int m = 0; m < 4; ++m) { const int row = row0 + ai * 128 + m * 16; float ss = 0.f;
#pragma unroll
                for (int bj = 0; bj < 2; ++bj)
#pragma unroll
                    for (int n = 0; n < 2; ++n) { const size_t o = (size_t)row * DM + col0 + bj * 128 + n * 16; const u32x2 xo = xv0[m][bj][n];
                        const f32x2 x01 = unpk_f16(xo.x), x23 = unpk_f16(xo.y); f32x4 xv = (f32x4){x01.x, x01.y, x23.x, x23.y};
                        xv += alpha * acc[ai][bj][m][n];
                        if (out) *(f32x4*)(out + o) = xv;
                        ss += (xv[0] * xv[0] + xv[1] * xv[1]) + (xv[2] * xv[2] + xv[3] * xv[3]);
                        u32x2 w; w.x = cvt_pk_f16(xv[0], xv[1]); w.y = cvt_pk_f16(xv[2], xv[3]); *(u32x2*)(xo_ + o) = w; }
                ss += __shfl_xor(ss, 16); ss += __shfl_xor(ss, 32);
                if (fq == 0) part[(size_t)row * 16 + u.pn * 4 + wc] = ss; }
        }
    }
};
__device__ __forceinline__ void head_norm_rope(float (&v)[2][8], const float* gain, const unsigned char* ws, unsigned rope_off, int fq, float scale) {
    float ss = 0.f;
#pragma unroll
    for (int bj = 0; bj < 2; ++bj)
#pragma unroll
        for (int e = 0; e < 8; ++e) ss += v[bj][e] * v[bj][e];
    ss += __shfl_xor(ss, 16); ss += __shfl_xor(ss, 32);
    const float inv = rsqrtf(ss * (1.0f / 64.0f) + EPS);
#pragma unroll
    for (int e4 = 0; e4 < 2; ++e4) {
        const f32x4 ga = *(const f32x4*)(gain + 8 * fq + 4 * e4), gb = *(const f32x4*)(gain + 32 + 8 * fq + 4 * e4);
        const f32x4 c01 = *(const f32x4*)(ws + rope_off + (unsigned)(8 * fq + 4 * e4) * 8u), c23 = *(const f32x4*)(ws + rope_off + (unsigned)(8 * fq + 4 * e4 + 2) * 8u);
        const float cs[4] = {c01[0], c01[2], c23[0], c23[2]}, sn[4] = {c01[1], c01[3], c23[1], c23[3]};
#pragma unroll
        for (int j = 0; j < 4; ++j) { const int e = 4 * e4 + j; const float x1 = v[0][e] * inv * ga[j], x2 = v[1][e] * inv * gb[j];
            v[0][e] = (x1 * cs[j] - x2 * sn[j]) * scale; v[1][e] = (x2 * cs[j] + x1 * sn[j]) * scale; }
    }
}
struct EpiWin {
    static constexpr bool AGROUP = false;
    static constexpr bool F16 = true;
    static constexpr bool PERM = true;
    const float* q_norm; const float* k_norm; unsigned char* ws;
    __device__ __forceinline__ void operator()(AccRef acc, const Unit& u, int wr, int wc, int fr, int fq) const {
        const int row0 = u.pm * 256 + wr * 64 + fr; const int pn = win_role(u.pn);
#pragma unroll
        for (int am = 0; am < 4; ++am) { const int ai = am >> 1;
            float rsv[2];
#pragma unroll
            for (int m2 = 0; m2 < 2; ++m2) rsv[m2] = rowscale4((const float*)(ws + (unsigned)OFF_PART), row0 + ai * 128 + ((am & 1) * 2 + m2) * 16, fq);
#pragma unroll
            for (int m2 = 0; m2 < 2; ++m2) { const int m = (am & 1) * 2 + m2;
                const unsigned row = (unsigned)(row0 + ai * 128 + m * 16);
                const float rs = rsv[m2]; const unsigned b = row >> 12, s = row & 4095u;
                float v[2][8];
#pragma unroll
                for (int bj = 0; bj < 2; ++bj)
#pragma unroll
                    for (int n = 0; n < 2; ++n)
#pragma unroll
                        for (int j = 0; j < 4; ++j) v[bj][4 * n + j] = acc[ai][bj][m][n][j] * rs;
                if (pn < 2) {
#pragma unroll
                    for (int bj = 0; bj < 2; ++bj) { const unsigned lc = 256u * pn + 64u * wc + 32u * bj + 8u * fq; const unsigned g = lc >> 4, c0 = lc & 15u;
                        *(u32x4*)(ws + (unsigned)OFF_AG + ((g * 512u + (row >> 5)) * 640u + (row & 31u) * 16u + c0) * 2u) = pack8(v[bj]); }
                } else if (pn < 4) {
                    const unsigned h = (unsigned)(pn - 2) * 4u + wc;
                    head_norm_rope(v, q_norm, ws, (unsigned)OFF_ROPE + s * 256u, fq, QSCALE);
                    const unsigned o = (unsigned)OFF_QN + ((((b * 2u + (h >> 2)) * 4096u + s) * 4u + (h & 3u)) * 64u + 8u * fq) * 2u;
                    *(u32x4*)(ws + o) = pack8(v[0]); *(u32x4*)(ws + o + 64u) = pack8(v[1]);
                } else if (pn == 4) {
                    const unsigned g = wc & 1; const unsigned o = (unsigned)(wc < 2 ? OFF_KCR : OFF_VCR) + (((b * 2u + g) * 4096u + s) * 64u + 8u * fq) * 2u;
                    *(u32x4*)(ws + o) = pack8(v[0]); *(u32x4*)(ws + o + 64u) = pack8(v[1]);
                } else if (pn < 7) {
                    const unsigned g = wc & 1;
                    if (wc < 2) {
                        head_norm_rope(v, k_norm + (pn == 5 ? 64 : 128), ws, (unsigned)OFF_ROPE + s * 256u, fq, 1.0f);
                        const unsigned o = (unsigned)(pn == 5 ? OFF_KSEL : OFF_KWIN) + (((b * 2u + g) * 4096u + s) * 64u + 8u * fq) * 2u;
                        *(u32x4*)(ws + o) = pack8(v[0]); *(u32x4*)(ws + o + 64u) = pack8(v[1]);
                    } else {
                        const unsigned o = (unsigned)(pn == 5 ? OFF_VSELT : OFF_VWINT) + (((b * 2u + g) * 4096u + s) * 64u + 8u * fq) * 2u;
                        *(u32x4*)(ws + o) = pack8(v[0]); *(u32x4*)(ws + o + 64u) = pack8(v[1]);
                    }
                } else if (pn < 15) {
                    const unsigned t = (unsigned)(pn - 7) & 3u; const unsigned o = (unsigned)(pn < 11 ? OFF_GA : OFF_GB) + (row * 1024u + 256u * t + 64u * wc + 8u * fq) * 2u;
#pragma unroll
                    for (int bj = 0; bj < 2; ++bj) { float oo[8];
#pragma unroll
                        for (int e = 0; e < 8; ++e) oo[e] = sigmoidf_(v[bj][e]);
                        *(u32x4*)(ws + o + 64u * bj) = pack8(oo); }
                } else {
                    if (wc == 0 && fq < 3) { const unsigned o = (unsigned)OFF_NGATE + (row * 24u + 8u * fq) * 4u;
                        f32x4 a, c;
#pragma unroll
                        for (int e = 0; e < 4; ++e) { a[e] = sigmoidf_(v[0][e]); c[e] = sigmoidf_(v[0][4 + e]); }
                        *(f32x4*)(ws + o) = a; *(f32x4*)(ws + o + 16u) = c; }
                }
            }
        }
    }
};
struct EpiS5A {
    static constexpr bool AGROUP = false;
    static constexpr bool F16 = false;
    static constexpr bool PERM = false; float* E;
    __device__ __forceinline__ void operator()(AccRef acc, const Unit& u, int wr, int wc, int fr, int fq) const {
        const int row0 = u.pm * 256 + wr * 64 + fr, col0 = wc * 32 + 4 * fq;
#pragma unroll
        for (int ai = 0; ai < 2; ++ai)
#pragma unroll
            for (int m = 0; m < 4; ++m) { const int row = row0 + ai * 128 + m * 16;
#pragma unroll
                for (int n = 0; n < 2; ++n) *(f32x4*)(E + ((size_t)u.z * 512 + row) * 128 + col0 + n * 16) = acc[ai][0][m][n]; }
    }
};
struct EpiS5C {
    static constexpr bool AGROUP = false;
    static constexpr bool F16 = false;
    static constexpr bool PERM = true; bf16_t* y;
    __device__ __forceinline__ void operator()(AccRef acc, const Unit& u, int wr, int wc, int fr, int fq) const {
        const int row0 = u.pm * 256 + wr * 64 + fr;
#pragma unroll
        for (int ai = 0; ai < 2; ++ai)
#pragma unroll
            for (int m = 0; m < 4; ++m) { const int row = row0 + ai * 128 + m * 16;
#pragma unroll
                for (int bj = 0; bj < 2; ++bj) { const int col = 256 * u.pn + 128 * bj + 32 * wc + 8 * fq; const int i = col >> 4, c0 = col & 15; float o[8];
#pragma unroll
                    for (int n = 0; n < 2; ++n)
#pragma unroll
                        for (int j = 0; j < 4; ++j) o[4 * n + j] = gelu_tanh(acc[ai][bj][m][n][j]);
                    *(u32x4*)(y + (size_t)u.z * pg8::AGS + ((size_t)row * 32 + i) * 16 + c0) = pack8(o); } }
    }
};
struct EpiGLU {
    static constexpr bool AGROUP = true;
    static constexpr bool F16 = false;
    static constexpr bool PERM = true; bf16_t* ga;
    __device__ __forceinline__ void operator()(AccRef acc, const Unit& u, int wr, int wc, int fr, int fq) const {
        const int row0 = u.pm * 256 + wr * 64 + fr, col0 = u.pn * 128 + wc * 32 + 8 * fq;
        const bf16_t* __restrict__ gin = ga; bf16_t* __restrict__ gout = ga;
        u32x4 gv[2][4];
#pragma unroll
        for (int ai = 0; ai < 2; ++ai)
#pragma unroll
            for (int m = 0; m < 4; ++m) gv[ai][m] = *(const u32x4*)(gin + (size_t)(row0 + ai * 128 + m * 16) * 1024 + col0);
#pragma unroll
        for (int ai = 0; ai < 2; ++ai)
#pragma unroll
            for (int m = 0; m < 4; ++m) { const int row = row0 + ai * 128 + m * 16; float o[8];
#pragma unroll
                for (int n = 0; n < 2; ++n)
#pragma unroll
                    for (int j = 0; j < 4; ++j) { const int e = 4 * n + j; const unsigned w = gv[ai][m][e >> 1]; const float gaf = __uint_as_float((e & 1) ? (w & 0xffff0000u) : (w << 16));
                        o[e] = gaf * acc[ai][0][m][n][j] * sigmoidf_(acc[ai][1][m][n][j]); }
                *(u32x4*)(gout + (size_t)row * 1024 + col0) = pack8(o); }
    }
};
struct EpiUp {
    static constexpr bool AGROUP = false;
    static constexpr bool F16 = false;
    static constexpr bool PERM = true; bf16_t* mg; const bf16_t* gb;
    __device__ __forceinline__ void operator()(AccRef acc, const Unit& u, int wr, int wc, int fr, int fq) const {
        const int row0 = u.pm * 256 + wr * 64 + fr;
        const bf16_t* __restrict__ min_ = mg; bf16_t* __restrict__ mout = mg; const bf16_t* __restrict__ gbr = gb;
#pragma unroll
        for (int ai = 0; ai < 2; ++ai)
#pragma unroll
          for (int mh = 0; mh < 2; ++mh) {
            u32x4 mv[2][2], gv[2][2];
#pragma unroll
            for (int m2 = 0; m2 < 2; ++m2)
#pragma unroll
                for (int bj = 0; bj < 2; ++bj) { const size_t o = (size_t)(row0 + ai * 128 + (2 * mh + m2) * 16) * 1024 + 256 * u.pn + 128 * bj + 32 * wc + 8 * fq; mv[m2][bj] = *(const u32x4*)(min_ + o); gv[m2][bj] = *(const u32x4*)(gbr + o); }
#pragma unroll
            for (int m2 = 0; m2 < 2; ++m2)
#pragma unroll
                for (int bj = 0; bj < 2; ++bj) { const int m = 2 * mh + m2; const size_t o = (size_t)(row0 + ai * 128 + m * 16) * 1024 + 256 * u.pn + 128 * bj + 32 * wc + 8 * fq; float r[8];
#pragma unroll
                    for (int n = 0; n < 2; ++n)
#pragma unroll
                        for (int j = 0; j < 4; ++j) { const int e = 4 * n + j; const unsigned wm = mv[m2][bj][e >> 1], wg = gv[m2][bj][e >> 1];
                            const float mf = __uint_as_float((e & 1) ? (wm & 0xffff0000u) : (wm << 16)), gf = __uint_as_float((e & 1) ? (wg & 0xffff0000u) : (wg << 16));
                            r[e] = mf + gf * acc[ai][bj][m][n][j]; }
                    *(u32x4*)(mout + o) = pack8(r); }
          }
    }
};
struct EpiCmp1 {
    static constexpr bool AGROUP = false;
    static constexpr bool F16 = false;
    static constexpr bool PERM = false; float* cp;
    __device__ __forceinline__ void operator()(AccRef acc, const Unit& u, int wr, int wc, int fr, int fq) const {
        const int row0 = u.pm * 256 + wr * 64 + fr, col0 = wc * 32 + 4 * fq;
#pragma unroll
        for (int ai = 0; ai < 2; ++ai)
#pragma unroll
            for (int m = 0; m < 4; ++m) { const int row = row0 + ai * 128 + m * 16;
#pragma unroll
                for (int n = 0; n < 2; ++n) *(f32x4*)(cp + ((size_t)u.z * 2048 + row) * 128 + col0 + n * 16) = acc[ai][0][m][n]; }
    }
};

struct ConvTile { const float* src; const float* gain; bf16_t* dst; int srcN, K, base, valid, p, k0, f16; };
__device__ __forceinline__ ConvTile conv_decode(const Params& P, int l, int job) {
    unsigned char* ws = P.ws + ((l & 1) ? OFF_WALT : 0);
    const int ntile[10] = {704, 352, 704, 352, 512, 128, 64, 128, 32, 32};
    int mi = 0, t = job;
    while (mi < 9 && t >= ntile[mi]) { t -= ntile[mi]; ++mi; }
    ConvTile c; c.gain = nullptr; int kind = 0, half = 0; c.f16 = (mi == 0 || mi == 2 || mi == 4) ? 1 : 0;
    switch (mi) {
        case 0: c.src = P.ffn1_wi + (size_t)l * 1024 * 5632; c.gain = P.norm_ffn1 + l * 1024; c.dst = (bf16_t*)(ws + OFF_WI1); c.srcN = 5632; c.K = 1024; kind = 1; half = 2816; break;
        case 1: c.src = P.ffn1_wo + (size_t)l * 2816 * 1024; c.dst = (bf16_t*)(ws + OFF_WO1); c.srcN = 1024; c.K = 2816; break;
        case 2: c.src = P.ffn2_wi + (size_t)l * 1024 * 5632; c.gain = P.norm_ffn2 + l * 1024; c.dst = (bf16_t*)(ws + OFF_WI2); c.srcN = 5632; c.K = 1024; kind = 1; half = 2816; break;
        case 3: c.src = P.ffn2_wo + (size_t)l * 2816 * 1024; c.dst = (bf16_t*)(ws + OFF_WO2); c.srcN = 1024; c.K = 2816; break;
        case 4: c.src = P.w_in + (size_t)l * 1024 * 3864; c.gain = P.norm_mix + l * 1024; c.dst = (bf16_t*)(ws + OFF_WIN); c.srcN = 3864; c.K = 1024; kind = 3; break;
        case 5: c.src = P.w_glu + (size_t)l * 512 * 2048; c.dst = (bf16_t*)(ws + OFF_WGLU); c.srcN = 2048; c.K = 512; kind = 1; half = 1024; break;
        case 6: c.src = P.w_up + (size_t)l * 512 * 1024; c.dst = (bf16_t*)(ws + OFF_WUP); c.srcN = 1024; c.K = 512; break;
        case 7: c.src = P.w_out + (size_t)l * 1024 * 1024; c.dst = (bf16_t*)(ws + OFF_WOUT); c.srcN = 1024; c.K = 1024; break;
        case 8: c.src = P.cmp_w1 + ((size_t)l * 2 + 0) * 2048 * 128; c.dst = (bf16_t*)(ws + OFF_CW1); c.srcN = 128; c.K = 2048; break;
        default: c.src = P.cmp_w1 + ((size_t)l * 2 + 1) * 2048 * 128; c.dst = (bf16_t*)(ws + OFF_CW1) + 256 * 2048; c.srcN = 128; c.K = 2048; break;
    }
    const int nkt = c.K >> 8; const int q = t / nkt, kt = t % nkt; c.k0 = kt * 256; const int p = q * 32; c.p = p; c.valid = 32;
    if (kind == 0) c.base = p;
    else if (kind == 1) { const int pn = p >> 8, bj = (p >> 7) & 1, xx = p & 127; c.base = bj * half + pn * 128 + xx; }
    else { const int pn = win_role(p >> 8), pp = p & 255; const int lc = 64 * ((pp >> 5) & 3) + 32 * (pp >> 7); const int LC = 256 * pn + lc;
        if (LC < 1792) c.base = LC; else if (LC < 3840) c.base = LC + 24; else if (LC == 3840) { c.base = 1792; c.valid = 24; } else { c.base = 0; c.valid = 0; } }
    return c;
}
__device__ __forceinline__ void conv_load(const ConvTile& c, float (&v)[16], int tid) {
    const int col = tid & 31;
#pragma unroll
    for (int it = 0; it < 16; ++it) { const int k = it * 16 + (tid >> 5); v[it] = col < c.valid ? c.src[(size_t)(c.k0 + k) * c.srcN + c.base + col] : 0.f; }
    if (c.gain) {
#pragma unroll
        for (int it = 0; it < 16; ++it) v[it] *= c.gain[c.k0 + it * 16 + (tid >> 5)]; }
}
__device__ __forceinline__ void conv_store(const ConvTile& c, const float (&v)[16], LAS float* T, int tid) {
    const int col = tid & 31;
#pragma unroll
    for (int it = 0; it < 16; ++it) T[(it * 16 + (tid >> 5)) * 33 + col] = v[it];
    __syncthreads();
#pragma unroll
    for (int it = 0; it < 8; ++it) { const int r = it * 4 + (tid >> 7), kk = (tid & 127) * 2;
        const float a0 = T[kk * 33 + r], a1 = T[(kk + 1) * 33 + r];
        *(unsigned*)(c.dst + (size_t)(c.p + r) * c.K + c.k0 + kk) = c.f16 ? cvt_pk_f16(a0, a1) : cvt_pk_bf16(a0, a1); }
    __syncthreads();
}
__device__ __forceinline__ void prep_jobs(const Params& P, int l, LAS unsigned char* lds, int j0, int j1, int wi, int wn) {
    const int tid = opaque_tid();
    int job = j0 + wi;
    if (wi < 0 || job >= j1) return;
    ConvTile cur = conv_decode(P, l, job); float v[16]; conv_load(cur, v, tid);
    for (;;) {
        const int nj = job + wn; const bool more = nj < j1; ConvTile nxt = cur; float w[16];
        if (more) { nxt = conv_decode(P, l, nj); conv_load(nxt, w, tid); }
        conv_store(cur, v, (LAS float*)lds, tid);
        if (!more) break;
#pragma unroll
        for (int it = 0; it < 16; ++it) v[it] = w[it];
        cur = nxt; job = nj;
    }
}

__device__ __forceinline__ void phase_init_a(const Params& P, LAS unsigned char* lds) {
    unsigned char* ws = P.ws; const int tid = opaque_tid(), lane = tid & 63, wave = tid >> 6;
    for (int job = opaque_bid(); job < 2048 + 256 + 544 + 16; job += gridDim.x) {
        if (job >= 2048 + 256 + 544) {
            const int jj = job - (2048 + 256 + 544); const int lz = jj >> 1, h = (jj & 1) * 64 + lane; LAS float* red = (LAS float*)lds;
            const float* pe = P.cmp_pe + (size_t)lz * 2048 + wave * 256; const float* w1 = P.cmp_w1 + ((size_t)lz * 2048 + wave * 256) * 128 + h; float s0 = 0.f, s1 = 0.f, s2 = 0.f, s3 = 0.f;
            for (int k = 0; k < 256; k += 4) { s0 += pe[k] * w1[(size_t)k * 128]; s1 += pe[k + 1] * w1[(size_t)(k + 1) * 128]; s2 += pe[k + 2] * w1[(size_t)(k + 2) * 128]; s3 += pe[k + 3] * w1[(size_t)(k + 3) * 128]; }
            __syncthreads(); red[wave * 64 + lane] = (s0 + s1) + (s2 + s3); __syncthreads();
            if (wave == 0) { float t = 0.f; for (int w = 0; w < 8; ++w) t += red[w * 64 + lane]; ((float*)(ws + OFF_CBIAS))[lz * 128 + h] = t; }
            continue;
        }
        if (job < 2048) {
            const int row = job * 8 + wave; float ss = 0.f;
#pragma unroll
            for (int k = 0; k < 4; ++k) { const size_t o = (size_t)row * 1024 + k * 256 + lane * 4; const f32x4 v = *(const f32x4*)(P.x + o);
                ss += (v[0] * v[0] + v[1] * v[1]) + (v[2] * v[2] + v[3] * v[3]); u32x2 w; w.x = cvt_pk_f16(v[0], v[1]); w.y = cvt_pk_f16(v[2], v[3]); *(u32x2*)((bf16_t*)(ws + OFF_XB) + o) = w; }
#pragma unroll
            for (int sft = 32; sft >= 1; sft >>= 1) ss += __shfl_xor(ss, sft);
            if (lane < 16) ((float*)(ws + OFF_PART))[(size_t)row * 16 + lane] = lane == 0 ? ss : 0.f;
        } else if (job < 2048 + 256) {
            const int idx = (job - 2048) * 512 + tid; const int pos = idx >> 5, i = idx & 31;
            const float inv_freq = 1.0f / powf(10000.0f, (float)i / 32.0f); const float ang = (float)pos * inv_freq;
            f32x2 cs; cs.x = (float)cos((double)ang); cs.y = (float)sin((double)ang); ((f32x2*)(ws + OFF_ROPE))[idx] = cs;
        } else {
            const int e = (job - 2048 - 256) * 512 + tid; const int idx = e / 34, tau = e - idx * 34, lg = idx >> 6;
            const float dt = expf(P.log_dt[lg]); const float lr = P.lam_re[idx], li = P.lam_im[idx];
            const int tt = tau == 33 ? 1 : tau;
            const float mg = expf(lr * dt * (float)tt), an = li * dt * (float)tt; const float ar = mg * cosf(an), aim = mg * sinf(an);
            if (tau != 33) { f32x2 v; v.x = ar; v.y = aim; ((f32x2*)(ws + OFF_POW))[e] = v; }
            else {
                const float inv = 1.0f / (lr * lr + li * li); const float nr = ar - 1.0f, ni = aim;
                const float fr_ = (nr * lr + ni * li) * inv, fi_ = (ni * lr - nr * li) * inv;
                f32x4 br4[4], bi4[4];
#pragma unroll
                for (int q = 0; q < 4; ++q) { br4[q] = *(const f32x4*)(P.b_re + (size_t)idx * 16 + 4 * q); bi4[q] = *(const f32x4*)(P.b_im + (size_t)idx * 16 + 4 * q); }
                f32x4* bb = (f32x4*)(ws + OFF_BBAR) + (size_t)idx * 8;
#pragma unroll
                for (int q = 0; q < 4; ++q)
#pragma unroll
                    for (int h2 = 0; h2 < 2; ++h2) { const float b0r = br4[q][2 * h2], b0i = bi4[q][2 * h2], b1r = br4[q][2 * h2 + 1], b1i = bi4[q][2 * h2 + 1];
                        bb[2 * q + h2] = (f32x4){fr_ * b0r - fi_ * b0i, fr_ * b0i + fi_ * b0r, fr_ * b1r - fi_ * b1i, fr_ * b1i + fi_ * b1r}; }
            }
        }
    }
}
__device__ __forceinline__ void phase_init_b(const Params& P, LAS unsigned char* lds) {
    unsigned char* ws = P.ws; const int tid = opaque_tid();
    const f32x2* POW = (const f32x2*)(ws + OFF_POW); const f32x2* BB = (const f32x2*)(ws + OFF_BBAR);
    for (int job = opaque_bid(); job < 128 + 512 + 512; job += gridDim.x) {
        if (job < 128) {
            const int lg = job; const int c = tid & 15, tau = tid >> 4;
            LAS f32x2* BBs = (LAS f32x2*)lds; LAS float* Crs = (LAS float*)(lds + 8192); LAS float* Cis = (LAS float*)(lds + 12288); LAS f32x2* PWs = (LAS f32x2*)(lds + 16384);
            __syncthreads();
            { const f32x2 b0 = BB[(size_t)lg * 1024 + tid], b1 = BB[(size_t)lg * 1024 + 512 + tid];
              const float r0 = P.c_re[(size_t)lg * 1024 + tid], r1 = P.c_re[(size_t)lg * 1024 + 512 + tid], i0 = P.c_im[(size_t)lg * 1024 + tid], i1 = P.c_im[(size_t)lg * 1024 + 512 + tid];
              f32x2 pv[5];
#pragma unroll
              for (int q = 0; q < 5; ++q) { const int o = tid + 512 * q; pv[q] = o < 2176 ? POW[(size_t)lg * 2176 + o] : (f32x2){0.f, 0.f}; }
              BBs[tid] = b0; BBs[512 + tid] = b1; Crs[tid] = r0; Crs[512 + tid] = r1; Cis[tid] = i0; Cis[512 + tid] = i1;
#pragma unroll
              for (int q = 0; q < 5; ++q) { const int o = tid + 512 * q; if (o < 2176) PWs[o] = pv[q]; } }
            __syncthreads();
            float acc[16];
#pragma unroll
            for (int q = 0; q < 16; ++q) acc[q] = 0.f;
#pragma unroll 4
            for (int n = 0; n < 64; ++n) { const float cr = Crs[c * 64 + n], ci = Cis[c * 64 + n];
                const f32x2 pw = PWs[n * 34 + tau]; const float wr_ = cr * pw.x - ci * pw.y, wi_ = cr * pw.y + ci * pw.x; const LAS f32x4* bb = (const LAS f32x4*)(BBs + n * 16);
#pragma unroll
                for (int q = 0; q < 8; ++q) { const f32x4 v = bb[q]; acc[2 * q] += wr_ * v[0] - wi_ * v[1]; acc[2 * q + 1] += wr_ * v[2] - wi_ * v[3]; } }
            { const float dsk = tau == 0 ? P.ssm_d[(size_t)lg * 16 + c] : 0.f;
#pragma unroll
              for (int q = 0; q < 16; ++q) acc[q] += (q == c) ? dsk : 0.f; }
            float* dst = (float*)(ws + OFF_KG) + ((size_t)lg * 512 + tid) * 16;
#pragma unroll
            for (int q = 0; q < 4; ++q) *(f32x4*)(dst + 4 * q) = (f32x4){acc[4 * q], acc[4 * q + 1], acc[4 * q + 2], acc[4 * q + 3]};
        } else if (job < 128 + 512) {
            f32x2 pwv[4]; f32x4 bbv[4][4];
#pragma unroll
            for (int u = 0; u < 4; ++u) { const int e = ((job - 128) * 4 + u) * 512 + tid; const int k8 = e & 63, nn = (e >> 6) & 127, lg = e >> 13; const int n = nn >> 1, k0 = k8 * 8, j = k0 >> 4, cp0 = k0 & 15;
                const size_t sn = (size_t)lg * 64 + n; pwv[u] = POW[sn * 34 + (31 - j)];
#pragma unroll
                for (int q = 0; q < 4; ++q) bbv[u][q] = *(const f32x4*)(BB + sn * 16 + cp0 + 2 * q); }
#pragma unroll
            for (int u = 0; u < 4; ++u) { const int e = ((job - 128) * 4 + u) * 512 + tid; const int k8 = e & 63, nn = (e >> 6) & 127, lg = e >> 13; const int ri = nn & 1, k0 = k8 * 8; const f32x2 pw = pwv[u]; float o[8];
#pragma unroll
                for (int q = 0; q < 4; ++q) { const f32x4 v = bbv[u][q];
                    o[2 * q] = ri ? (pw.x * v[1] + pw.y * v[0]) : (pw.x * v[0] - pw.y * v[1]); o[2 * q + 1] = ri ? (pw.x * v[3] + pw.y * v[2]) : (pw.x * v[2] - pw.y * v[3]); }
                *(u32x4*)((bf16_t*)(ws + OFF_PT) + ((size_t)lg * 128 + nn) * 512 + k0) = pack8(o); }
        } else {
            f32x4 crv[4], civ[4]; f32x2 pwq[4][4];
#pragma unroll
            for (int u = 0; u < 4; ++u) { const int e = ((job - 128 - 512) * 4 + u) * 512 + tid; const int n4 = e & 15, ic = (e >> 4) & 511, lg = e >> 13; const int n0 = n4 * 4, i = ic >> 4, c = ic & 15;
                crv[u] = *(const f32x4*)(P.c_re + ((size_t)lg * 16 + c) * 64 + n0); civ[u] = *(const f32x4*)(P.c_im + ((size_t)lg * 16 + c) * 64 + n0);
#pragma unroll
                for (int q = 0; q < 4; ++q) pwq[u][q] = POW[((size_t)lg * 64 + n0 + q) * 34 + i + 1]; }
#pragma unroll
            for (int u = 0; u < 4; ++u) { const int e = ((job - 128 - 512) * 4 + u) * 512 + tid; const int n4 = e & 15, ic = (e >> 4) & 511, lg = e >> 13; const int n0 = n4 * 4; float o[8];
#pragma unroll
                for (int q = 0; q < 4; ++q) { const f32x2 pw = pwq[u][q]; o[2 * q] = crv[u][q] * pw.x - civ[u][q] * pw.y; o[2 * q + 1] = -(crv[u][q] * pw.y + civ[u][q] * pw.x); }
                *(u32x4*)((bf16_t*)(ws + OFF_TQ) + ((size_t)lg * 512 + ic) * 640 + 512 + 2 * n0) = pack8(o); }
        }
    }
}
__device__ __forceinline__ void phase_init_c(const Params& P) {
    unsigned char* ws = P.ws; const int tid = opaque_tid(); const float* KG = (const float*)(ws + OFF_KG);
    for (int job = opaque_bid(); job < 8192; job += gridDim.x) {
        const int e = job * 512 + tid; const int k8 = e & 63, ic = (e >> 6) & 511, lg = e >> 15; const int k0 = k8 * 8, j = k0 >> 4, c0 = k0 & 15, i = ic >> 4, c = ic & 15;
        u32x4 w = (u32x4){0u, 0u, 0u, 0u};
        if (j <= i) { const float* src = KG + ((size_t)lg * 32 + (i - j)) * 256 + c * 16 + c0; const f32x4 a = *(const f32x4*)src, b = *(const f32x4*)(src + 4);
            w.x = cvt_pk_bf16(a[0], a[1]); w.y = cvt_pk_bf16(a[2], a[3]); w.z = cvt_pk_bf16(b[0], b[1]); w.w = cvt_pk_bf16(b[2], b[3]); }
        *(u32x4*)((bf16_t*)(ws + OFF_TQ) + ((size_t)lg * 512 + ic) * 640 + k0) = w;
    }
}

__device__ __forceinline__ void phase_p5(const Params& P, int l, LAS unsigned char* lds) {
    unsigned char* ws = P.ws; const int tid = opaque_tid(), lane = tid & 63, wave = tid >> 6;
    for (int job = opaque_bid(); job < 128 + 512; job += gridDim.x) {
        if (job < 128) {
            const int g = job >> 2, b = job & 3, n = lane, seg = wave; LAS f32x2* Ls = (LAS f32x2*)lds;
            const f32x2 a32 = ((const f32x2*)(ws + OFF_POW))[(((size_t)l * 32 + g) * 64 + n) * 34 + 32];
            const float* E = (const float*)(ws + OFF_E) + ((size_t)g * 512 + b * 128 + seg * 16) * 128 + 2 * n;
            bf16_t* Ag = (bf16_t*)(ws + OFF_AG) + ((size_t)g * 512 + b * 128 + seg * 16) * 640 + 512 + 2 * n;
            f32x2 ev[16];
#pragma unroll
            for (int i = 0; i < 16; ++i) ev[i] = *(const f32x2*)(E + (size_t)i * 128);
            float sr = 0.f, si = 0.f;
#pragma unroll
            for (int i = 0; i < 16; ++i) { const float nr = a32.x * sr - a32.y * si + ev[i].x, ni = a32.x * si + a32.y * sr + ev[i].y; sr = nr; si = ni; }
            __syncthreads();
            Ls[seg * 64 + n] = (f32x2){sr, si};
            float pr = a32.x, pi = a32.y;
#pragma unroll
            for (int q = 0; q < 4; ++q) { const float tr = pr * pr - pi * pi, ti = 2.f * pr * pi; pr = tr; pi = ti; }
            __syncthreads();
            sr = 0.f; si = 0.f;
            for (int s2 = 0; s2 < seg; ++s2) { const f32x2 L = Ls[s2 * 64 + n]; const float nr = pr * sr - pi * si + L.x, ni = pr * si + pi * sr + L.y; sr = nr; si = ni; }
#pragma unroll
            for (int i = 0; i < 16; ++i) { *(unsigned*)(Ag + (size_t)i * 640) = cvt_pk_bf16(sr, si);
                const float nr = a32.x * sr - a32.y * si + ev[i].x, ni = a32.x * si + a32.y * sr + ev[i].y; sr = nr; si = ni; }
        } else {
            const int j2 = job - 128; LAS float* Hs = (LAS float*)lds;
            const float* cp = (const float*)(ws + OFF_CPART); const float* cb = (const float*)(ws + OFF_CBIAS) + l * 256;
            __syncthreads();
            LAS float* W2s = (LAS float*)(lds + 4096);
            { const int zj = (j2 * 8) >> 11; const float* w2g = P.cmp_w2 + ((size_t)l * 2 + zj) * 128 * 64; float wv[16];
#pragma unroll
              for (int q = 0; q < 16; ++q) wv[q] = w2g[tid + 512 * q];
#pragma unroll
              for (int q = 0; q < 16; ++q) W2s[tid + 512 * q] = wv[q]; }
            { float pv[2][9];
#pragma unroll
              for (int h2 = 0; h2 < 2; ++h2) { const int id = tid + h2 * 512; const int rr = id >> 7, h = id & 127; const int R = j2 * 8 + rr; const int z = R >> 11, r = R & 2047;
                  pv[h2][8] = cb[z * 128 + h];
#pragma unroll
                  for (int sp = 0; sp < 8; ++sp) pv[h2][sp] = cp[(((size_t)z * 8 + sp) * 2048 + r) * 128 + h]; }
#pragma unroll
              for (int h2 = 0; h2 < 2; ++h2) { float s2 = pv[h2][8];
#pragma unroll
                  for (int sp = 0; sp < 8; ++sp) s2 += pv[h2][sp];
                  Hs[tid + h2 * 512] = gelu_tanh(s2); } }
            __syncthreads();
            const int R = j2 * 8 + wave; const int z = R >> 11, r = R & 2047; const int bg = r >> 8, n = r & 255;
            const float* w2 = P.cmp_w2 + ((size_t)l * 2 + z) * 128 * 64; float o = 0.f;
            { float o0 = 0.f, o1 = 0.f, o2 = 0.f, o3 = 0.f;
#pragma unroll 8
              for (int h = 0; h < 128; h += 4) { o0 += Hs[wave * 128 + h] * W2s[h * 64 + lane]; o1 += Hs[wave * 128 + h + 1] * W2s[(h + 1) * 64 + lane]; o2 += Hs[wave * 128 + h + 2] * W2s[(h + 2) * 64 + lane]; o3 += Hs[wave * 128 + h + 3] * W2s[(h + 3) * 64 + lane]; }
              o = (o0 + o1) + (o2 + o3); }
            if (z == 0) {
                float ss = o * o;
#pragma unroll
                for (int sft = 32; sft >= 1; sft >>= 1) ss += __shfl_xor(ss, sft);
                const float xn = o * rsqrtf(ss * (1.0f / 64.0f) + EPS) * P.k_norm[(size_t)l * 192 + lane];
                const float other = __shfl_xor(xn, 32); const int pos = 16 * n + 31; const int i = lane & 31;
                f32x2 cs = (f32x2){1.f, 0.f}; if (n < 255) cs = ((const f32x2*)(ws + OFF_ROPE))[(size_t)pos * 32 + i];
                float res = lane < 32 ? (xn * cs.x - other * cs.y) : (xn * cs.x + other * cs.y);
                if (n == 255) res = 0.f;
                ((bf16_t*)(ws + OFF_KCN))[((size_t)bg * 256 + n) * 64 + lane] = f2bf(res);
            } else {
                ((bf16_t*)(ws + OFF_VCT))[((size_t)bg * 64 + lane) * 256 + n] = f2bf(n == 255 ? 0.f : o);
            }
        }
    }
}

#define MFMA16(a, b, c) __builtin_amdgcn_mfma_f32_16x16x32_bf16((a), (b), (c), 0, 0, 0)
constexpr int ATT_KS = 0, ATT_VS = 18432, ATT_P = 36864;
constexpr float SOFF = 8.0f;
template <int MODE, bool Q0, bool Q1, int VSTR = 72>
__device__ __forceinline__ void tile_compute(const LAS bf16_t* Kb, const LAS bf16_t* Vb, const bf16x8 (&qf)[2][2], const int (&tq)[2], const float (&sinit)[2], bool boundary, int key0,
                                             f32x4 (&O)[2][4], float (&lrow)[2], int fr, int g4) {
    bf16x8 kf[4][2]; s16x4 vlo[2][4], vhi[2][4];
#pragma unroll
    for (int kt = 0; kt < 4; ++kt)
#pragma unroll
        for (int ks = 0; ks < 2; ++ks) kf[kt][ks] = *(const LAS bf16x8*)(Kb + (16 * kt + fr) * 72 + 32 * ks + 8 * g4);
    __builtin_amdgcn_sched_barrier(0);
    f32x4 S[2][4];
#pragma unroll
    for (int qi = 0; qi < 2; ++qi)
#pragma unroll
        for (int kt = 0; kt < 4; ++kt) S[qi][kt] = (f32x4){sinit[qi], sinit[qi], sinit[qi], sinit[qi]};
#pragma unroll
    for (int kt = 0; kt < 4; ++kt)
#pragma unroll
        for (int ks = 0; ks < 2; ++ks) { if (Q0) S[0][kt] = MFMA16(kf[kt][ks], qf[0][ks], S[0][kt]); if (Q1) S[1][kt] = MFMA16(kf[kt][ks], qf[1][ks], S[1][kt]); }
    __builtin_amdgcn_sched_barrier(0);
#pragma unroll
    for (int s2 = 0; s2 < 2; ++s2)
#pragma unroll
        for (int dt = 0; dt < 4; ++dt) { vlo[s2][dt] = *(const LAS s16x4*)(Vb + (16 * dt + fr) * VSTR + 32 * s2 + 4 * g4); vhi[s2][dt] = *(const LAS s16x4*)(Vb + (16 * dt + fr) * VSTR + 32 * s2 + 16 + 4 * g4); }
    __builtin_amdgcn_sched_barrier(0);
    bf16x8 pf[2][2];
#pragma unroll
    for (int qi = 0; qi < 2; ++qi) {
        if ((qi == 0 && Q0) || (qi == 1 && Q1)) {
            const int t = tq[qi]; float rs = 0.f;
#pragma unroll
            for (int kt = 0; kt < 4; ++kt)
#pragma unroll
                for (int j = 0; j < 4; ++j) { float p = fexp2(S[qi][kt][j]);
                    if (boundary) { const int key = key0 + 16 * kt + 4 * g4 + j; bool valid;
                        if (MODE == 0) valid = key <= t; else if (MODE == 1) valid = key <= t && (t - key) < 512; else valid = (16 * key + 31) <= t;
                        p = valid ? p : 0.f; }
                    S[qi][kt][j] = p; rs += p; }
            lrow[qi] += rs;
#pragma unroll
            for (int s2 = 0; s2 < 2; ++s2) { u32x4 w; w.x = cvt_pk_bf16(S[qi][2 * s2][0], S[qi][2 * s2][1]); w.y = cvt_pk_bf16(S[qi][2 * s2][2], S[qi][2 * s2][3]);
                w.z = cvt_pk_bf16(S[qi][2 * s2 + 1][0], S[qi][2 * s2 + 1][1]); w.w = cvt_pk_bf16(S[qi][2 * s2 + 1][2], S[qi][2 * s2 + 1][3]); pf[qi][s2] = __builtin_bit_cast(bf16x8, w); }
        }
    }
#pragma unroll
    for (int s2 = 0; s2 < 2; ++s2)
#pragma unroll
        for (int dt = 0; dt < 4; ++dt) { const bf16x8 vf = __builtin_shufflevector(vlo[s2][dt], vhi[s2][dt], 0, 1, 2, 3, 4, 5, 6, 7);
            if (Q0) O[0][dt] = MFMA16(vf, pf[0][s2], O[0][dt]);
            if (Q1) O[1][dt] = MFMA16(vf, pf[1][s2], O[1][dt]); }
}
template <int MODE>
__device__ __forceinline__ void flash_pass(LAS unsigned char* lds, const bf16_t* __restrict__ Kg, const bf16_t* __restrict__ Vg, int vstride, int tb, int te,
                                           const bf16x8 (&qf)[2][2], const int (&tq)[2], const unsigned long long (&sm)[2], f32x4 (&O)[2][4], float (&mrow)[2], float (&lrow)[2], int tid, int lane) {
    const int fr = lane & 15, g4 = lane >> 4; const int lr = tid >> 3, lch = tid & 7; const int vkey = tid & 63, vch = tid >> 6;
    LAS bf16_t* Ks = (LAS bf16_t*)(lds + ATT_KS); LAS bf16_t* Vs = (LAS bf16_t*)(lds + ATT_VS);
#define FP_LOADV(tile_) (MODE == 2 ? *(const u32x4*)(Vg + (size_t)lr * vstride + (tile_) * 64 + lch * 8) : *(const u32x4*)(Vg + (size_t)((tile_) * 64 + vkey) * 64 + vch * 8))
#define FP_STOREV(buf_, r_) do { LAS bf16_t* _vb = Vs + (buf_) * 64 * 72; \
        if (MODE == 2) *(LAS u32x4*)(_vb + lr * 72 + lch * 8) = (r_); \
        else { _Pragma("unroll") for (int _e = 0; _e < 8; ++_e) { const unsigned _w = (r_)[_e >> 1]; _vb[(vch * 8 + _e) * 72 + vkey] = (bf16_t)((_e & 1) ? (_w >> 16) : (_w & 0xffffu)); } } } while (0)
    u32x4 kreg = *(const u32x4*)(Kg + (size_t)(tb * 64 + lr) * 64 + lch * 8);
    u32x4 vreg = FP_LOADV(tb);
    __syncthreads();
    *(LAS u32x4*)(Ks + lr * 72 + lch * 8) = kreg; FP_STOREV(0, vreg);
    __syncthreads();
    for (int tile = tb; tile < te; ++tile) {
        const int buf = (tile - tb) & 1; const bool more = tile + 1 < te;
        if (more) { kreg = *(const u32x4*)(Kg + (size_t)((tile + 1) * 64 + lr) * 64 + lch * 8); vreg = FP_LOADV(tile + 1); }
        const LAS bf16_t* Kb = Ks + buf * 64 * 72; const LAS bf16_t* Vb = Vs + buf * 64 * 72;
        const int key0 = tile * 64;
        bool need[2]; float sinit[2];
#pragma unroll
        for (int qi = 0; qi < 2; ++qi) { bool sel = true; if (MODE == 0) sel = ((sm[qi] >> tile) & 1ull) != 0ull; sinit[qi] = sel ? -SOFF : -1e30f; need[qi] = MODE == 0 ? (__ballot(sel) != 0ull) : true; }
        const bool boundary = MODE == 2 ? true : (MODE == 0 ? (tile == te - 1) : (tile == te - 1 || tile + 8 == te - 1));
        if (need[0] && need[1]) tile_compute<MODE, true, true>(Kb, Vb, qf, tq, sinit, boundary, key0, O, lrow, fr, g4);
        else if (MODE == 0 && need[0]) tile_compute<MODE, true, false>(Kb, Vb, qf, tq, sinit, boundary, key0, O, lrow, fr, g4);
        else if (MODE == 0 && need[1]) tile_compute<MODE, false, true>(Kb, Vb, qf, tq, sinit, boundary, key0, O, lrow, fr, g4);
        if (more) { *(LAS u32x4*)(Ks + (buf ^ 1) * 64 * 72 + lr * 72 + lch * 8) = kreg; FP_STOREV(buf ^ 1, vreg); }
        asm volatile("s_waitcnt lgkmcnt(0)" ::: "memory"); __builtin_amdgcn_s_barrier(); asm volatile("" ::: "memory");
    }
#undef FP_LOADV
#undef FP_STOREV
}

constexpr int CK_OFF = 0, CV_OFF = 36864, CP_OFF = 70656, CV_STR = 264;
__device__ __forceinline__ float dpp_xor1(float x) { return __int_as_float(__builtin_amdgcn_update_dpp(0, __float_as_int(x), 0xB1, 0xf, 0xf, true)); }
__device__ __forceinline__ float dpp_xor2(float x) { return __int_as_float(__builtin_amdgcn_update_dpp(0, __float_as_int(x), 0x4E, 0xf, 0xf, true)); }
__device__ __forceinline__ void cmp_item(const Params& P, int bg, int qt, LAS unsigned char* lds) {
    unsigned char* ws = P.ws; const int tid = opaque_tid(), lane = tid & 63, wave = tid >> 6, fr = lane & 15, g4 = lane >> 4;
    const int b = bg >> 1, g = bg & 1, t0 = qt * 64;
    const bf16_t* Q = (const bf16_t*)(ws + OFF_QN) + (((size_t)bg * 4096 + t0) * 4 + 32 * wave) * 64;
    bf16x8 qf[2][2]; int tq[2];
#pragma unroll
    for (int qi = 0; qi < 2; ++qi) { tq[qi] = t0 + 8 * wave + 4 * qi + (fr >> 2);
#pragma unroll
        for (int ks = 0; ks < 2; ++ks) qf[qi][ks] = *(const bf16x8*)(Q + (size_t)(16 * qi + fr) * 64 + 32 * ks + 8 * g4); }
    const bf16_t* Kc = (const bf16_t*)(ws + OFF_KCN) + (size_t)bg * 256 * 64; const bf16_t* Vc = (const bf16_t*)(ws + OFF_VCT) + (size_t)bg * 64 * 256;
    const int te = ((4 * qt + 2) >> 6) + 1;
    LAS bf16_t* Ka = (LAS bf16_t*)(lds + CK_OFF); LAS bf16_t* Va = (LAS bf16_t*)(lds + CV_OFF); LAS float* Pb = (LAS float*)(lds + CP_OFF);
    { const int lr = tid >> 3, lch = tid & 7;
      __syncthreads();
      for (int tile = 0; tile < te; ++tile) {
          *(LAS u32x4*)(Ka + (tile * 64 + lr) * 72 + lch * 8) = *(const u32x4*)(Kc + (size_t)(tile * 64 + lr) * 64 + lch * 8);
          *(LAS u32x4*)(Va + lr * CV_STR + tile * 64 + lch * 8) = *(const u32x4*)(Vc + (size_t)lr * 256 + tile * 64 + lch * 8); }
      __syncthreads(); }
    f32x4 O[2][4]; float lrow[2] = {0.f, 0.f}; const float sinit[2] = {-SOFF, -SOFF};
#pragma unroll
    for (int qi = 0; qi < 2; ++qi)
#pragma unroll
        for (int dt = 0; dt < 4; ++dt) O[qi][dt] = (f32x4){0.f, 0.f, 0.f, 0.f};
    for (int tile = 0; tile < te; ++tile) tile_compute<2, true, true, CV_STR>(Ka + tile * 64 * 72, Va + tile * 64, qf, tq, sinit, true, tile * 64, O, lrow, fr, g4);
    float linv[2];
#pragma unroll
    for (int qi = 0; qi < 2; ++qi) { float lt = lrow[qi]; lt += __shfl_xor(lt, 16); lt += __shfl_xor(lt, 32); linv[qi] = lt > 0.f ? 1.0f / lt : 0.f; }
    const float* ng = (const float*)(ws + OFF_NGATE);
#pragma unroll
    for (int qi = 0; qi < 2; ++qi) { const int t = tq[qi], r = fr & 3, h = g * 4 + r; const size_t tok = (size_t)b * 4096 + t; const float gc = ng[tok * 24 + h * 3 + 0] * linv[qi];
#pragma unroll
        for (int dt = 0; dt < 4; ++dt) { u32x2 w; w.x = cvt_pk_bf16(O[qi][dt][0] * gc, O[qi][dt][1] * gc); w.y = cvt_pk_bf16(O[qi][dt][2] * gc, O[qi][dt][3] * gc);
            *(u32x2*)((bf16_t*)(ws + OFF_OC) + tok * 512 + h * 64 + 16 * dt + 4 * g4) = w; } }
    for (int tile = 0; tile < te; ++tile) {
        const LAS bf16_t* Kb = Ka + tile * 64 * 72;
#pragma unroll
        for (int kt = 0; kt < 4; ++kt) { f32x4 S0 = (f32x4){-SOFF, -SOFF, -SOFF, -SOFF}, S1 = S0;
#pragma unroll
            for (int ks = 0; ks < 2; ++ks) { const bf16x8 kf = *(const LAS bf16x8*)(Kb + (16 * kt + fr) * 72 + 32 * ks + 8 * g4); S0 = MFMA16(kf, qf[0][ks], S0); S1 = MFMA16(kf, qf[1][ks], S1); }
#pragma unroll
            for (int qi = 0; qi < 2; ++qi) { f32x4 pv;
#pragma unroll
                for (int j = 0; j < 4; ++j) { const int key = tile * 64 + 16 * kt + 4 * g4 + j; const bool valid = (16 * key + 31) <= tq[qi]; const float sv = qi ? S1[j] : S0[j];
                    float p = valid ? fexp2(sv) * linv[qi] : 0.f; p += dpp_xor1(p); p += dpp_xor2(p); pv[j] = p; }
                if ((fr & 3) == 0) *(LAS f32x4*)(Pb + (8 * wave + 4 * qi + (fr >> 2)) * 256 + tile * 64 + 16 * kt + 4 * g4) = pv; }
        }
    }
    __syncthreads();
    for (int rp = 0; rp < (((REP_MASK >> 16) & 1) ? 2 : 1); ++rp)
    for (int tk = 0; tk < 8; ++tk) {
        const int ti = 8 * wave + tk, t = t0 + ti; const LAS float* Pr = Pb + ti * 256; const int nmax = t >= 31 ? ((t - 31) >> 4) : -1; const int j = lane;
        float imp = 0.f;
        { const int n0 = 4 * j;
          if (n0 - 1 >= 0 && n0 - 1 <= nmax) imp += 0.5f * Pr[n0 - 1];
          if (n0 <= nmax) imp += Pr[n0];
          if (n0 + 1 <= nmax) imp += Pr[n0 + 1];
          if (n0 + 2 <= nmax) imp += Pr[n0 + 2];
          if (n0 + 3 <= nmax) imp += 0.5f * Pr[n0 + 3]; }
        const int cur = t >> 6; const bool valid = j <= cur, forced = (j == 0) || (j == cur) || (j == cur - 1);
        unsigned long long mask;
        if (cur < 16) mask = (2ull << cur) - 1ull;
        else {
            const unsigned u = valid ? __float_as_uint(forced ? 1e4f : imp) : 0u;
            unsigned T = 0u;
            for (int bit = 30; bit >= 0; --bit) { const unsigned cand = T | (1u << bit); if (__popcll(__ballot(u >= cand)) >= 16) T = cand; }
            const unsigned long long gt = __ballot(u > T), eq = __ballot(u == T); const int need = 16 - __popcll(gt);
            const int below = __popcll(eq & ((1ull << j) - 1ull));
            mask = gt | __ballot(u == T && below < need);
        }
        if (lane == 0) ((unsigned long long*)(ws + OFF_SELM))[(size_t)bg * 4096 + t] = mask;
    }
    __syncthreads();
}

__device__ __forceinline__ void attn_item(const Params& P, int bg, int qt, LAS unsigned char* lds) {
    unsigned char* ws = P.ws; const int tid = opaque_tid(), lane = tid & 63, wave = tid >> 6, fr = lane & 15, g4 = lane >> 4;
    const int b = bg >> 1, g = bg & 1, t0 = qt * 64;
    const bf16_t* Q = (const bf16_t*)(ws + OFF_QN) + (((size_t)bg * 4096 + t0) * 4 + 32 * wave) * 64;
    bf16x8 qf[2][2]; int tq[2]; unsigned long long sm[2];
#pragma unroll
    for (int qi = 0; qi < 2; ++qi) { tq[qi] = t0 + 8 * wave + 4 * qi + (fr >> 2); sm[qi] = ((const unsigned long long*)(ws + OFF_SELM))[(size_t)bg * 4096 + tq[qi]];
#pragma unroll
        for (int ks = 0; ks < 2; ++ks) qf[qi][ks] = *(const bf16x8*)(Q + (size_t)(16 * qi + fr) * 64 + 32 * ks + 8 * g4); }
    f32x4 O[2][4]; float mrow[2], lrow[2]; LAS f32x4* Rl = (LAS f32x4*)(lds + ATT_P);
    const float* ng = (const float*)(ws + OFF_NGATE);
    for (int pass = 0; pass < 2; ++pass) {
#pragma unroll
        for (int qi = 0; qi < 2; ++qi) { mrow[qi] = -1e30f; lrow[qi] = 0.f;
#pragma unroll
            for (int dt = 0; dt < 4; ++dt) O[qi][dt] = (f32x4){0.f, 0.f, 0.f, 0.f}; }
        if (pass == 0) flash_pass<0>(lds, (const bf16_t*)(ws + OFF_KSEL) + (size_t)bg * 4096 * 64, (const bf16_t*)(ws + OFF_VSELT) + (size_t)bg * 4096 * 64, 64, 0, qt + 1, qf, tq, sm, O, mrow, lrow, tid, lane);
        else flash_pass<1>(lds, (const bf16_t*)(ws + OFF_KWIN) + (size_t)bg * 4096 * 64, (const bf16_t*)(ws + OFF_VWINT) + (size_t)bg * 4096 * 64, 64, qt >= 8 ? qt - 8 : 0, qt + 1, qf, tq, sm, O, mrow, lrow, tid, lane);
#pragma unroll
        for (int qi = 0; qi < 2; ++qi) { float lt = lrow[qi]; lt += __shfl_xor(lt, 16); lt += __shfl_xor(lt, 32); const int h = g * 4 + (fr & 3); const size_t tok = (size_t)b * 4096 + tq[qi];
            const float gsc = ng[tok * 24 + h * 3 + 1 + pass] * (lt > 0.f ? 1.0f / lt : 0.f);
#pragma unroll
            for (int dt = 0; dt < 4; ++dt) { if (pass == 0) Rl[(qi * 4 + dt) * 512 + tid] = O[qi][dt] * gsc; else O[qi][dt] = O[qi][dt] * gsc + Rl[(qi * 4 + dt) * 512 + tid]; } }
    }
    { u32x2 cvv[2][4];
#pragma unroll
      for (int qi = 0; qi < 2; ++qi) { const int h = g * 4 + (fr & 3); const size_t tok = (size_t)b * 4096 + tq[qi];
#pragma unroll
          for (int dt = 0; dt < 4; ++dt) cvv[qi][dt] = *(const u32x2*)((const bf16_t*)(ws + OFF_OC) + tok * 512 + h * 64 + 16 * dt + 4 * g4); }
#pragma unroll
      for (int qi = 0; qi < 2; ++qi) { const int h = g * 4 + (fr & 3); const size_t tok = (size_t)b * 4096 + tq[qi];
#pragma unroll
          for (int dt = 0; dt < 4; ++dt) { const size_t o = tok * 512 + h * 64 + 16 * dt + 4 * g4; const u32x2 cv = cvv[qi][dt];
              const float c0 = __uint_as_float(cv.x << 16), c1 = __uint_as_float(cv.x & 0xffff0000u), c2 = __uint_as_float(cv.y << 16), c3 = __uint_as_float(cv.y & 0xffff0000u);
              u32x2 w; w.x = cvt_pk_bf16(O[qi][dt][0] + c0, O[qi][dt][1] + c1); w.y = cvt_pk_bf16(O[qi][dt][2] + c2, O[qi][dt][3] + c3);
              *(u32x2*)((bf16_t*)(ws + OFF_NSA) + o) = w; } } }
}

#define XB_TMO      128
#define XB_XCNT(j)  (256  + 64 * (j))
#define XB_XSUB(j)  (1280 + 64 * (j))
#define XB_XGEN(j)  (2304 + 64 * (j))
#define XB_TOP      3328
#define XB_TOPGEN   3392
#define XCD_BAR_WORDS 3456
#define XB_SPIN_CAP (1u << 18)
__device__ __forceinline__ unsigned xb_ld(unsigned* p)              { return __hip_atomic_load(p, __ATOMIC_RELAXED, __HIP_MEMORY_SCOPE_AGENT); }
__device__ __forceinline__ unsigned xb_add(unsigned* p, unsigned v) { return __hip_atomic_fetch_add(p, v, __ATOMIC_RELAXED, __HIP_MEMORY_SCOPE_AGENT); }
__device__ __forceinline__ unsigned xb_xcc_id() { return (unsigned)__builtin_amdgcn_s_getreg((3 << 11) | 20) & 0xFu; }
#define XB_SPIN(cond, bar) do { unsigned _sp = 0; while (cond) { __builtin_amdgcn_s_sleep(1); \
    if ((++_sp & 255u) == 0u) { if (xb_ld(&(bar)[XB_TMO])) break; if (_sp > XB_SPIN_CAP) { atomicAdd(&(bar)[XB_TMO], 1u); break; } } } } while (0)
struct XcdBarrier { unsigned* bar; unsigned x; volatile LAS unsigned* st; };
__device__ __forceinline__ XcdBarrier xcd_barrier_post(unsigned* bar, volatile LAS unsigned* st) {
    XcdBarrier b; b.bar = bar; b.x = xb_xcc_id(); b.st = st;
    if (threadIdx.x == 0) (void)xb_add(&bar[XB_XCNT(b.x)], 1u);
    return b;
}
__device__ __forceinline__ void xcd_barrier_complete(unsigned* bar, unsigned x, unsigned& nloc, unsigned& nx) {
    const unsigned G = gridDim.x * gridDim.y * gridDim.z;
    unsigned sum, cnt, mine, sp = 0u;
    for (;;) {
        sum = 0u; cnt = 0u; mine = 0u;
#pragma unroll
        for (unsigned j = 0; j < 16; ++j) { const unsigned c = xb_ld(&bar[XB_XCNT(j)]); sum += c; cnt += (c > 0u) ? 1u : 0u; mine = (j == x) ? c : mine; }
        if (sum == G) break;
        __builtin_amdgcn_s_sleep(1);
        if ((++sp & 255u) == 0u) { if (xb_ld(&bar[XB_TMO])) break; if (sp > XB_SPIN_CAP) { atomicAdd(&bar[XB_TMO], 1u); break; } }
    }
    nloc = mine > 0u ? mine : 1u; nx = cnt > 0u ? cnt : 1u;
}
__device__ __forceinline__ void xcd_barrier(const XcdBarrier& b) {
    asm volatile("s_waitcnt vmcnt(0)" ::: "memory");
    __syncthreads();
    if (threadIdx.x == 0) {
        unsigned* bar = b.bar;
        __builtin_amdgcn_s_waitcnt(0);
        unsigned nloc = b.st[0], nx = b.st[1];
        if (nloc == 0u) { xcd_barrier_complete(bar, b.x, nloc, nx); b.st[0] = nloc; b.st[1] = nx; }
        const unsigned old = xb_add(&bar[XB_XSUB(b.x)], 1u);
        const unsigned gen = old / nloc;
        if (old + 1u == (gen + 1u) * nloc) {
            __builtin_amdgcn_fence(__ATOMIC_RELEASE, "agent");
            asm volatile("s_waitcnt vmcnt(0)" ::: "memory");
            const unsigned og = xb_add(&bar[XB_TOP], 1u);
            const unsigned tg = og / nx;
            if (og + 1u == (tg + 1u) * nx) xb_add(&bar[XB_TOPGEN], 1u);
            else XB_SPIN(xb_ld(&bar[XB_TOPGEN]) == tg, bar);
            __builtin_amdgcn_fence(__ATOMIC_ACQUIRE, "agent");
            xb_add(&bar[XB_XGEN(b.x)], 1u);
            asm volatile("s_waitcnt vmcnt(0)" ::: "memory");
        } else {
            XB_SPIN(xb_ld(&bar[XB_XGEN(b.x)]) == gen, bar);
            __builtin_amdgcn_fence(__ATOMIC_ACQUIRE, "agent");
            asm volatile("s_waitcnt vmcnt(0)" ::: "memory");
        }
    }
    __syncthreads();
}

constexpr int N_INIT = 3, PH_PER_LAYER = 12, N_PHASES = N_INIT + NLAYER * PH_PER_LAYER;
__device__ __forceinline__ Gemm mk_gemm(const void* A, const void* Bt, int lda, int ldb, int K, int nM, int nN) {
    Gemm g; g.A = (const bf16_t*)A; g.Bt = (const bf16_t*)Bt; g.lda = lda; g.ldb = ldb; g.K = K; g.nM = nM; g.nN = nN; g.nZ = 1; g.nZ2 = 1; g.sA1 = g.sA2 = g.sB1 = g.sB2 = 0; return g;
}
#ifndef ONLY
#define ONLY -1
#endif
#define EN(x) (ONLY < 0 || ONLY == (x))
typedef const Params __attribute__((address_space(4)))* KParamsPtr;
__device__ __forceinline__ void run_phase(int ph, LAS unsigned char* lds) {
#if defined(__HIP_DEVICE_COMPILE__)
    unsigned long long kpa = (unsigned long long)__builtin_amdgcn_kernarg_segment_ptr(); asm volatile("" : "+s"(kpa));
    const Params P = *(KParamsPtr)kpa;
#else
    const Params P{};
#endif
    unsigned char* ws = P.ws; const int G = gridDim.x, c = opaque_bid();
    if (ph == 0) { if (EN(100)) phase_init_a(P, lds); return; }
    if (ph == 1) { if (EN(101)) phase_init_b(P, lds); return; }
    if (ph == 2) { if (EN(102)) phase_init_c(P); return; }
    const int l = (ph - N_INIT) / PH_PER_LAYER, sp = (ph - N_INIT) % PH_PER_LAYER;
    float* part = (float*)(ws + OFF_PART); bf16_t* xb = (bf16_t*)(ws + OFF_XB);
    unsigned char* wsw = ws + ((l & 1) ? OFF_WALT : 0);
    const bool ovl = (G == 256); const bool pre = ovl && l + 1 < NLAYER;
    int pj0 = 0, pj1 = 0, pwi = -1, pwn = 1;
    if (sp == 0) { if (!ovl || l == 0) { pj0 = 0; pj1 = 3008; pwi = c; pwn = G; } }
    else if (pre && sp == 1) { pj0 = 0; pj1 = 1024; pwi = c - 128; pwn = 128; }
    else if (pre && sp == 4) { pj0 = 1024; pj1 = 1504; pwi = c - 64; pwn = G - 64; }
    else if (pre && sp == 5) { pj0 = 1504; pj1 = 1984; pwi = c - 96; pwn = G - 96; }
    else if (pre && sp == 10) { pj0 = 1984; pj1 = 3008; pwi = c - 128; pwn = 128; }
    const int pl = sp == 0 ? l : l + 1;
    Sched S;
    switch (sp) {
    case 0: break;
    case 1: case 10: if (EN(1)) {
        Gemm g = mk_gemm(xb, wsw + (sp == 1 ? OFF_WI1 : OFF_WI2), 1024, 1024, 1024, 64, 22); S.init(g, G, c);
        EpiFFNup e; e.part = part; e.G = (bf16_t*)(ws + OFF_G); pg8::gemm_phase(lds, g, S, e); } break;
    case 2: case 11: if (EN(2)) {
        Gemm g = mk_gemm(ws + OFF_G, wsw + (sp == 2 ? OFF_WO1 : OFF_WO2), 2816, 2816, 2816, 64, 4); S.init(g, G, c);
        EpiResid e; e.out = (l == NLAYER - 1 && sp == 11) ? P.out : nullptr; e.xb = xb; e.part = part; e.alpha = ((REP_MASK >> 2) & 1) ? 0.25f : 0.5f; pg8::gemm_phase(lds, g, S, e); } break;
    case 3: if (EN(3)) {
        Gemm g = mk_gemm(xb, wsw + OFF_WIN, 1024, 1024, 1024, 64, 16); S.init(g, G, c);
        EpiWin e; e.q_norm = P.q_norm + l * 64; e.k_norm = P.k_norm + l * 192; e.ws = ws; pg8::gemm_phase(lds, g, S, e); } break;
    case 4: if (EN(4)) {
        if (c < 64 || G < 192) {
            Gemm g = mk_gemm(ws + OFF_AG, ws + OFF_PT + (size_t)l * 32 * 128 * 512 * 2, 640, 512, 512, 2, 1); g.nZ = 32; g.sA1 = 512 * 640; g.sB1 = 128 * 512;
            S.init(g, G < 192 ? G : 64, c); EpiS5A e; e.E = (float*)(ws + OFF_E); pg8::gemm_phase(lds, g, S, e); }
        if (c >= 64 || G < 192) {
            Gemm g = mk_gemm(ws + OFF_KCR, wsw + OFF_CW1, 1024, 2048, 256, 8, 1); g.nZ = 16; g.nZ2 = 8; g.sA1 = (long)((OFF_VCR - OFF_KCR) / 2); g.sA2 = 256; g.sB1 = 256 * 2048; g.sB2 = 256;
            S.init(g, G < 192 ? G : 128, G < 192 ? c : (c < 192 ? c - 64 : -1)); EpiCmp1 e; e.cp = (float*)(ws + OFF_CPART); pg8::gemm_phase(lds, g, S, e); }
        } break;
    case 5: if (EN(5)) phase_p5(P, l, lds); break;
    case 6: if (EN(6)) {
        Gemm g = mk_gemm(ws + OFF_AG, ws + OFF_TQ + (size_t)l * 32 * 512 * 640 * 2, 640, 640, 640, 2, 2); g.nZ = 32; g.sA1 = 512 * 640; g.sB1 = 512 * 640; S.init(g, G, c);
        EpiS5C e; e.y = (bf16_t*)(ws + OFF_Y); pg8::gemm_phase(lds, g, S, e);
        {
            const bool bal = G == 256; const int cnt = bal ? (c < 128 ? 1 : 3) : 512;
            for (int k = 0; k < cnt; ++k) {
                int bg, qt;
                if (bal) { if (c >= 128 && k == 2) { const int ci = c - 128; bg = ci >> 4; qt = ci & 15; }
                           else { const int ei = c < 128 ? c : 128 + 2 * (c - 128) + k; bg = ei / 48; qt = 16 + ei % 48; } }
                else { const int it = c + k * G; if (it >= 512) break; bg = it >> 6; qt = it & 63; }
                cmp_item(P, bg, qt, lds); } } } break;
    case 7: if (EN(7)) {
        for (int rep = 0; rep < (((REP_MASK >> 7) & 1) ? 2 : 1); ++rep)
        for (int it2 = 2 * c; it2 < 512; it2 += ((it2 & 1) ? 2 * G - 1 : 1)) { const int it = it2 >> 1; const int bg = it >> 5, qa = it & 31; attn_item(P, bg, (it2 & 1) ? qa : 63 - qa, lds); }
        __syncthreads();
        Gemm g = mk_gemm(ws + OFF_Y, wsw + OFF_WGLU, 512, 512, 512, 64, 8); S.init(g, G, c);
        EpiGLU e; e.ga = (bf16_t*)(ws + OFF_GA); pg8::gemm_phase(lds, g, S, e); } break;
    case 8: if (EN(8)) {
        Gemm g = mk_gemm(ws + OFF_NSA, wsw + OFF_WUP, 512, 512, 512, 64, 4); S.init(g, G, c);
        EpiUp e; e.mg = (bf16_t*)(ws + OFF_GA); e.gb = (const bf16_t*)(ws + OFF_GB); pg8::gemm_phase(lds, g, S, e); } break;
    case 9: if (EN(9)) {
        Gemm g = mk_gemm(ws + OFF_GA, wsw + OFF_WOUT, 1024, 1024, 1024, 64, 4); S.init(g, G, c);
        EpiResid e; e.out = nullptr; e.xb = xb; e.part = part; e.alpha = ((REP_MASK >> 9) & 1) ? 0.5f : 1.0f; pg8::gemm_phase(lds, g, S, e); } break;
    }
    if (pwi >= 0 && pj1 > pj0) { __syncthreads(); prep_jobs(P, pl, lds, pj0, pj1, pwi, pwn); }
}

__global__ void __launch_bounds__(512) mega(Params P) {
    extern __shared__ __attribute__((aligned(16))) unsigned char lds_raw[];
    LAS unsigned char* lds = (LAS unsigned char*)lds_raw;
    volatile LAS unsigned* st = (volatile LAS unsigned*)(lds + LDS_WORK);
    if (threadIdx.x == 0) { st[0] = 0u; st[1] = 0u; }
    __syncthreads();
    XcdBarrier bar; bar.bar = (unsigned*)(P.ws + OFF_BAR); bar.x = 0; bar.st = st;
    if (P.ph1 - P.ph0 > 1) bar = xcd_barrier_post((unsigned*)(P.ws + OFF_BAR), st);
    for (int ph = P.ph0; ph < P.ph1; ++ph) {
        if (ph >= N_INIT + PH_PER_LAYER && (ph - N_INIT) % PH_PER_LAYER == 0 && gridDim.x == 256 && P.ph1 - P.ph0 > 1) continue;
        int nrep = 1; if (REP_MASK) { const int bit = ph < N_INIT ? 12 + ph : (ph - N_INIT) % PH_PER_LAYER; if (bit != 7 && ((REP_MASK >> bit) & 1)) nrep = 2; }
        for (int r = 0; r < nrep; ++r) { if (r) __syncthreads(); run_phase(ph, lds); }
        if (ph + 1 < P.ph1) {
            if (P.ph0 < 0) { __threadfence(); cg::this_grid().sync(); }
            xcd_barrier(bar); if ((REP_MASK >> 15) & 1) xcd_barrier(bar);
        }
    }
}

extern "C" void kernel_launch(void* const* d_in, const int* in_sizes, int n_in, void* d_out, int out_size, void* d_ws, size_t ws_size, hipStream_t stream) {
    static int grid = 0;
    if (grid == 0) {
        if (n_in != 25 || out_size != NTOK * DM || ws_size < WS_END) { fprintf(stderr, "kernel_launch: unexpected shapes (n_in %d out %d ws %zu need %zu)\n", n_in, out_size, ws_size, (size_t)WS_END); grid = -1; return; }
        int dev = 0, cus = 0, per_cu = 0;
        hipGetDevice(&dev); hipDeviceGetAttribute(&cus, hipDeviceAttributeMultiprocessorCount, dev);
        if (hipFuncSetAttribute((const void*)mega, hipFuncAttributeMaxDynamicSharedMemorySize, LDS_BYTES) != hipSuccess) { fprintf(stderr, "hipFuncSetAttribute failed\n"); grid = -1; return; }
        if (hipOccupancyMaxActiveBlocksPerMultiprocessor(&per_cu, (const void*)mega, 512, LDS_BYTES) != hipSuccess || per_cu < 1) { fprintf(stderr, "occupancy query: %d\n", per_cu); per_cu = 1; }
        (void)hipGetLastError();
        grid = cus * 1;
    }
    if (grid < 0) return;
    Params p{};
    const float** pp = (const float**)&p;
    for (int i = 0; i < 25; ++i) pp[i] = (const float*)d_in[i];
    p.out = (float*)d_out; p.ws = (unsigned char*)d_ws;
    if (hipMemsetAsync((char*)d_ws + OFF_BAR, 0, 16384, stream) != hipSuccess) { fprintf(stderr, "memset failed\n"); return; }
#if MULTI_LAUNCH
    for (int ph = 0; ph < N_PHASES; ++ph) { p.ph0 = ph; p.ph1 = ph + 1; hipLaunchKernelGGL(mega, dim3(grid), dim3(512), LDS_BYTES, stream, p); }
#else
    p.ph0 = 0; p.ph1 = N_PHASES;
    void* args[] = {&p};
    hipError_t e = hipLaunchCooperativeKernel((const void*)mega, dim3(grid), dim3(512), args, LDS_BYTES, stream);
    if (e != hipSuccess) fprintf(stderr, "cooperative launch failed: %s (grid %d)\n", hipGetErrorString(e), grid);
#endif
}
```

```cpp
#include <hip/hip_runtime.h>
#include <hip/hip_cooperative_groups.h>
#include <cstdio>
namespace cg = cooperative_groups;

#ifndef REP_MASK
#define REP_MASK 0
#endif
#ifndef MULTI_LAUNCH
#define MULTI_LAUNCH 0
#endif

#define LAS __attribute__((address_space(3)))
typedef unsigned short bf16_t;
typedef short bf16x8 __attribute__((ext_vector_type(8)));
typedef short s16x4 __attribute__((ext_vector_type(4)));
typedef float f32x4 __attribute__((ext_vector_type(4)));
typedef float f32x2 __attribute__((ext_vector_type(2)));
typedef unsigned u32x4 __attribute__((ext_vector_type(4)));
typedef unsigned u32x2 __attribute__((ext_vector_type(2)));

constexpr int NTOK = 16384, DM = 1024, DFF = 2816, SEQ = 4096, NLAYER = 4;
constexpr int LDS_STAGE = 131072, LDS_WORK = 136192, LDS_BYTES = LDS_WORK + 16;
constexpr float EPS = 1e-6f;
constexpr float QSCALE = 0.125f * 1.4426950408889634f;

constexpr size_t SZ_WI = 5632ull * 1024 * 2, SZ_WO = 1024ull * 2816 * 2;
constexpr size_t OFF_WI1 = 0;
constexpr size_t OFF_WO1 = OFF_WI1 + SZ_WI;
constexpr size_t OFF_WI2 = OFF_WO1 + SZ_WO;
constexpr size_t OFF_WO2 = OFF_WI2 + SZ_WI;
constexpr size_t OFF_WIN = OFF_WO2 + SZ_WO;
constexpr size_t OFF_WGLU = OFF_WIN + 4096ull * 1024 * 2;
constexpr size_t OFF_WUP = OFF_WGLU + 2048ull * 512 * 2;
constexpr size_t OFF_WOUT = OFF_WUP + 1024ull * 512 * 2;
constexpr size_t OFF_CW1 = OFF_WOUT + 1024ull * 1024 * 2;
constexpr size_t OFF_CBIAS = OFF_CW1 + 2ull * 256 * 2048 * 2;
constexpr size_t OFF_POW = OFF_CBIAS + 4096;
constexpr size_t OFF_BBAR = OFF_POW + 4ull * 32 * 64 * 34 * 8;
constexpr size_t OFF_KG = OFF_BBAR + 4ull * 32 * 64 * 16 * 8;
constexpr size_t OFF_PT = OFF_KG + 4ull * 32 * 32 * 256 * 4;
constexpr size_t OFF_TQ = OFF_PT + 4ull * 32 * 128 * 512 * 2 + 128ull * 512 * 2;
constexpr size_t OFF_ROPE = OFF_TQ + 4ull * 32 * 512 * 640 * 2;
constexpr size_t OFF_XB = OFF_ROPE + 4096ull * 32 * 8;
constexpr size_t OFF_PART = OFF_XB + 16384ull * 1024 * 2;
constexpr size_t OFF_MIX = OFF_PART + 16384ull * 16 * 4;
constexpr size_t OFF_G = OFF_MIX;
constexpr size_t OFF_AG = OFF_MIX;
constexpr size_t OFF_NSA = OFF_AG;
constexpr size_t OFF_QN = OFF_AG + 32ull * 512 * 640 * 2;
constexpr size_t SZ_KV = 8ull * 4096 * 64 * 2;
constexpr size_t OFF_KCR = OFF_QN + 16384ull * 512 * 2;
constexpr size_t OFF_VCR = OFF_KCR + SZ_KV + 2048;
constexpr size_t OFF_KSEL = OFF_VCR + SZ_KV + 2048;
constexpr size_t OFF_VSELT = OFF_KSEL + SZ_KV;
constexpr size_t OFF_KWIN = OFF_VSELT + SZ_KV;
constexpr size_t OFF_VWINT = OFF_KWIN + SZ_KV;
constexpr size_t OFF_KCN = OFF_VWINT + SZ_KV;
constexpr size_t OFF_VCT = OFF_KCN + 8ull * 256 * 64 * 2;
constexpr size_t OFF_GA = OFF_VCT + 8ull * 256 * 64 * 2;
constexpr size_t OFF_GB = OFF_GA + 16384ull * 1024 * 2;
constexpr size_t OFF_NGATE = OFF_GB + 16384ull * 1024 * 2;
constexpr size_t OFF_Y = OFF_NGATE + 16384ull * 24 * 4;
constexpr size_t OFF_CPART = OFF_Y;
constexpr size_t OFF_OC = OFF_Y + 16384ull * 512 * 2;
constexpr size_t OFF_E = OFF_OC;
constexpr size_t OFF_SELM = OFF_OC + 16384ull * 512 * 2;
constexpr size_t OFF_BAR = OFF_SELM + 8ull * 4096 * 8;
constexpr size_t OFF_WALT = OFF_BAR + 16384;
constexpr size_t WS_END = OFF_WALT + OFF_CBIAS;
static_assert(OFF_G + 16384ull * 2816 * 2 <= WS_END, "G alias");
static_assert(2ull * 8 * 2048 * 128 * 4 <= 16384ull * 512 * 2, "cpart alias");

struct Params {
    const float *x, *norm_ffn1, *ffn1_wi, *ffn1_wo, *norm_mix, *w_in, *lam_re, *lam_im, *log_dt, *b_re, *b_im, *c_re, *c_im, *ssm_d, *w_glu,
        *q_norm, *k_norm, *cmp_pe, *cmp_w1, *cmp_w2, *w_up, *w_out, *norm_ffn2, *ffn2_wi, *ffn2_wo;
    float* out;
    unsigned char* ws;
    int ph0, ph1;
};

__device__ __forceinline__ int opaque_tid() { int t = threadIdx.x; asm volatile("" : "+v"(t)); return t; }
__device__ __forceinline__ int opaque_bid() { int t = blockIdx.x; asm volatile("" : "+s"(t)); return t; }
typedef __bf16 bf16x2_t __attribute__((ext_vector_type(2)));
__device__ __forceinline__ unsigned cvt_pk_bf16(float lo, float hi) { bf16x2_t v; v.x = (__bf16)lo; v.y = (__bf16)hi; return __builtin_bit_cast(unsigned, v); }
typedef _Float16 f16x2 __attribute__((ext_vector_type(2)));
typedef _Float16 f16x8 __attribute__((ext_vector_type(8)));
__device__ __forceinline__ unsigned cvt_pk_f16(float lo, float hi) { f16x2 v; v.x = (_Float16)lo; v.y = (_Float16)hi; return __builtin_bit_cast(unsigned, v); }
__device__ __forceinline__ f32x2 unpk_f16(unsigned w) { const f16x2 v = __builtin_bit_cast(f16x2, w); return (f32x2){(float)v.x, (float)v.y}; }
__device__ __forceinline__ bf16_t f2bf(float f) { return (bf16_t)(cvt_pk_bf16(f, 0.f) & 0xffffu); }
__device__ __forceinline__ float fexp2(float x) { return __builtin_amdgcn_exp2f(x); }
__device__ __forceinline__ float sigmoidf_(float x) { return __builtin_amdgcn_rcpf(1.0f + __builtin_amdgcn_exp2f(-1.4426950408889634f * x)); }
__device__ __forceinline__ float gelu_tanh(float x) { const float u = 0.7978845608028654f * (x + 0.044715f * x * x * x); return x * __builtin_amdgcn_rcpf(1.0f + __builtin_amdgcn_exp2f(-2.0f * 1.4426950408889634f * u)); }
__device__ __forceinline__ u32x4 pack8(const float (&o)[8]) { u32x4 w; w.x = cvt_pk_bf16(o[0], o[1]); w.y = cvt_pk_bf16(o[2], o[3]); w.z = cvt_pk_bf16(o[4], o[5]); w.w = cvt_pk_bf16(o[6], o[7]); return w; }
__device__ __forceinline__ float rowscale(const float* part, int row) {
    const f32x4* p = (const f32x4*)(part + (size_t)row * 16);
    const f32x4 a = p[0], b = p[1], c = p[2], d = p[3];
    const float s = ((a[0] + a[1]) + (a[2] + a[3])) + ((b[0] + b[1]) + (b[2] + b[3])) + ((c[0] + c[1]) + (c[2] + c[3])) + ((d[0] + d[1]) + (d[2] + d[3]));
    return rsqrtf(s * (1.0f / 1024.0f) + EPS);
}

__device__ __forceinline__ float rowscale4(const float* part, int row, int fq) {
    const f32x4 a = *(const f32x4*)(part + (size_t)row * 16 + 4 * fq);
    float s = (a[0] + a[1]) + (a[2] + a[3]); s += __shfl_xor(s, 16); s += __shfl_xor(s, 32);
    return rsqrtf(s * (1.0f / 1024.0f) + EPS);
}

__device__ __forceinline__ int win_role(int pn) { return pn == 4 ? 6 : (pn == 6 ? 4 : pn); }

namespace pg8 {
constexpr int BM = 256, BK = 64, HALF = 128, HTB = HALF * BK * 2, NXCD = 8, WGM = 8;
constexpr int AGS = 16384 * 16;
__device__ __forceinline__ int lds_byte(int r, int c) { const int st = (r >> 4) * 2 + (c >> 5), rr = r & 15, cc = c & 31, ob = rr * 64 + cc * 2; return st * 1024 + (ob ^ (((ob >> 9) & 1) << 5)); }
__device__ __forceinline__ void stage_rc(int b, int& R, int& C) { const int st = b / 1024, sb = b % 1024, swz = sb ^ (((sb >> 9) & 1) << 5); R = (st >> 1) * 16 + swz / 64; C = (st & 1) * 32 + (swz % 64) / 2; }
__device__ __forceinline__ int perm32(int rho) { const int n = rho >> 4, i = rho & 15; return 8 * (i >> 2) + 4 * n + (i & 3); }

struct Unit { int pm, pn, z; };
struct Gemm { const bf16_t* A; const bf16_t* Bt; int lda, ldb, K, nM, nN, nZ, nZ2; long sA1, sA2, sB1, sB2; };
struct Sched {
    int nM, nN, nwg, tot, G, c;
    __device__ __forceinline__ void init(const Gemm& g, int G_, int c_) { nM = g.nM; nN = g.nN; nwg = nM * nN; tot = nwg * g.nZ; G = G_; c = c_; }
    __device__ __forceinline__ bool next(int i, Unit& u) const {
        const long L = (long)i * G + c; if (c < 0 || L >= tot) return false;
        u.z = (int)(L / nwg); int wgid = (int)(L % nwg);
        { const int q = nwg / NXCD, r = nwg % NXCD, xcd = wgid % NXCD, off = wgid / NXCD; wgid = (xcd < r ? xcd * (q + 1) : r * (q + 1) + (xcd - r) * q) + off; }
        const int nig = WGM * nN, gid = wgid / nig, fm = gid * WGM, gsz = (nM - fm) < WGM ? (nM - fm) : WGM;
        u.pm = fm + ((wgid % nig) % gsz); u.pn = (wgid % nig) / gsz; return true;
    }
};

template <class Epi>
__device__ __forceinline__ void gemm_phase(LAS unsigned char* lds, const Gemm g, const Sched& S, const Epi& E) {
    const int tid = opaque_tid(), wid = __builtin_amdgcn_readfirstlane(tid >> 6), lane = tid & 63, wr = wid >> 2, wc = wid & 3, fr = lane & 15, fq = lane >> 4;
    const int K = g.K, nt = K / BK;
    unsigned voffA[2], voffB[2];
#pragma unroll
    for (int i = 0; i < 2; ++i) { int R, C; stage_rc(tid * 16 + i * 8192, R, C); const int Rb = Epi::PERM ? ((R & ~31) + perm32(R & 31)) : R;
        voffA[i] = Epi::AGROUP ? (unsigned)((C >> 4) * AGS + R * 16 + (C & 15)) * 2u : (unsigned)(R * g.lda + C) * 2u; voffB[i] = (unsigned)(Rb * g.ldb + C) * 2u; }
    const size_t kstep = (size_t)(BK * 2);
    const size_t kstepA = Epi::AGROUP ? (size_t)(BK / 16) * AGS * 2 : kstep;
    const size_t hstepA = Epi::AGROUP ? (size_t)HALF * 16 * 2 : (size_t)HALF * g.lda * 2, hstepB = (size_t)HALF * g.ldb * 2;
    const unsigned ldsw = (unsigned)wid * 1024u;
    const int aoff = lds_byte(wr * 64 + fr, fq * 8), boff = lds_byte(wc * 32 + fr, fq * 8);
#define PG8_SA(b, h) (((b) * 2 + (h)) * HTB)
#define PG8_SB(b, h) ((4 + (b) * 2 + (h)) * HTB)
#define PG8_STAGE(bufoff, gbase, voff) do { _Pragma("unroll") for (int _i = 0; _i < 2; ++_i) \
        __builtin_amdgcn_global_load_lds((const unsigned*)((const char*)(gbase) + (voff)[_i]), (LAS unsigned*)(lds + (bufoff) + ldsw + _i * 8192), 16, 0, 0); } while (0)
#define PG8_LDA(dst, b, h) do { _Pragma("unroll") for (int m = 0; m < 4; ++m) _Pragma("unroll") for (int k = 0; k < 2; ++k) dst[m][k] = *(const LAS bf16x8*)(lds + PG8_SA(b, h) + aoff + m * 2048 + k * 1024); } while (0)
#define PG8_LDB(dst, b, h) do { _Pragma("unroll") for (int n = 0; n < 2; ++n) _Pragma("unroll") for (int k = 0; k < 2; ++k) dst[n][k] = *(const LAS bf16x8*)(lds + PG8_SB(b, h) + boff + n * 2048 + k * 1024); } while (0)
#define PG8_MMA(ai, bj, At, Bt) do { __builtin_amdgcn_s_setprio(1); _Pragma("unroll") for (int m = 0; m < 4; ++m) _Pragma("unroll") for (int n = 0; n < 2; ++n) _Pragma("unroll") for (int k = 0; k < 2; ++k) \
        { if constexpr (Epi::F16) acc[ai][bj][m][n] = __builtin_amdgcn_mfma_f32_16x16x32_f16(__builtin_bit_cast(f16x8, Bt[n][k]), __builtin_bit_cast(f16x8, At[m][k]), acc[ai][bj][m][n], 0, 0, 0); \
          else acc[ai][bj][m][n] = __builtin_amdgcn_mfma_f32_16x16x32_bf16(Bt[n][k], At[m][k], acc[ai][bj][m][n], 0, 0, 0); } __builtin_amdgcn_s_setprio(0); } while (0)
#define PG8_WAIT_V(n) asm volatile("s_waitcnt vmcnt(" #n ")" ::: "memory")
#define PG8_WAIT_L(n) asm volatile("s_waitcnt lgkmcnt(" #n ")" ::: "memory")
#define PG8_BAR __builtin_amdgcn_s_barrier()
#define PG8_SCHED __builtin_amdgcn_sched_barrier(0)
#define PG8_ABASE(u) ((const char*)g.A + ((size_t)((u).z / g.nZ2) * g.sA1 + (size_t)((u).z % g.nZ2) * g.sA2 + (size_t)(u).pm * 256 * (Epi::AGROUP ? 16 : g.lda)) * 2)
#define PG8_BBASE(u) ((const char*)g.Bt + ((size_t)((u).z / g.nZ2) * g.sB1 + (size_t)((u).z % g.nZ2) * g.sB2 + (size_t)(u).pn * 256 * g.ldb) * 2)
    Unit cur, nxt; int ui = 0;
    if (!S.next(0, cur)) return;
    f32x4 acc[2][2][4][2];
#pragma unroll
    for (int a = 0; a < 2; ++a)
#pragma unroll
        for (int b = 0; b < 2; ++b)
#pragma unroll
            for (int m = 0; m < 4; ++m)
#pragma unroll
                for (int n = 0; n < 2; ++n) acc[a][b][m][n] = (f32x4){0.f, 0.f, 0.f, 0.f};
    bf16x8 At[4][2], B0[2][2], B1[2][2];
    const char* cA = PG8_ABASE(cur); const char* cB = PG8_BBASE(cur);
    PG8_STAGE(PG8_SB(0, 0), cB, voffB); PG8_STAGE(PG8_SA(0, 0), cA, voffA); PG8_STAGE(PG8_SB(0, 1), cB + hstepB, voffB); PG8_STAGE(PG8_SA(0, 1), cA + hstepA, voffA);
    if (wr == 1) PG8_BAR;
    PG8_WAIT_V(4); PG8_BAR;
    PG8_STAGE(PG8_SB(1, 0), cB + kstep, voffB); PG8_STAGE(PG8_SA(1, 0), cA + kstepA, voffA); PG8_STAGE(PG8_SB(1, 1), cB + hstepB + kstep, voffB);
    PG8_WAIT_V(6); PG8_BAR;
    for (;;) {
        const bool has_next = S.next(ui + 1, nxt);
        const char* nA = has_next ? PG8_ABASE(nxt) : cA; const char* nB = has_next ? PG8_BBASE(nxt) : cB;
        for (int t = 0; t < nt; t += 2) {
            const bool last = (t == nt - 2);
            const char* a1 = cA + (size_t)(t + 1) * kstepA;
            const char* a2 = last ? nA : cA + (size_t)(t + 2) * kstepA; const char* b2 = last ? nB : cB + (size_t)(t + 2) * kstep;
            const char* a3 = a2 + kstepA; const char* b3 = b2 + kstep;
            PG8_LDB(B0, 0, 0); PG8_SCHED; PG8_LDA(At, 0, 0); PG8_STAGE(PG8_SA(1, 1), a1 + hstepA, voffA);
            PG8_WAIT_L(8); PG8_BAR; PG8_WAIT_L(0); PG8_MMA(0, 0, At, B0); PG8_BAR; PG8_SCHED;
            PG8_LDB(B1, 0, 1); PG8_STAGE(PG8_SB(0, 0), b2, voffB);
            PG8_BAR; PG8_WAIT_L(0); PG8_MMA(0, 1, At, B1); PG8_BAR;
            PG8_LDA(At, 0, 1); PG8_STAGE(PG8_SA(0, 0), a2, voffA);
            PG8_BAR; PG8_WAIT_L(0); PG8_MMA(1, 0, At, B0); PG8_BAR; PG8_SCHED;
            PG8_STAGE(PG8_SB(0, 1), b2 + hstepB, voffB);
            PG8_WAIT_V(6); PG8_BAR; PG8_MMA(1, 1, At, B1); PG8_BAR;
            PG8_LDB(B0, 1, 0); PG8_SCHED; PG8_LDA(At, 1, 0); PG8_STAGE(PG8_SA(0, 1), a2 + hstepA, voffA);
            PG8_WAIT_L(8); PG8_BAR; PG8_WAIT_L(0); PG8_MMA(0, 0, At, B0); PG8_BAR; PG8_SCHED;
            PG8_LDB(B1, 1, 1); PG8_STAGE(PG8_SB(1, 0), b3, voffB);
            PG8_BAR; PG8_WAIT_L(0); PG8_MMA(0, 1, At, B1); PG8_BAR;
            PG8_LDA(At, 1, 1); PG8_STAGE(PG8_SA(1, 0), a3, voffA);
            PG8_BAR; PG8_WAIT_L(0); PG8_MMA(1, 0, At, B0); PG8_BAR; PG8_SCHED;
            PG8_STAGE(PG8_SB(1, 1), b3 + hstepB, voffB);
            PG8_WAIT_V(6); PG8_BAR; PG8_MMA(1, 1, At, B1); PG8_BAR;
        }
        { int efr = fr, efq = fq, ewr = wr, ewc = wc; asm volatile("" : "+v"(efr), "+v"(efq), "+s"(ewr), "+s"(ewc));
          E(acc, cur, ewr, ewc, efr, efq); }
        if (!has_next) break;
#pragma unroll
        for (int a = 0; a < 2; ++a)
#pragma unroll
            for (int b = 0; b < 2; ++b)
#pragma unroll
                for (int m = 0; m < 4; ++m)
#pragma unroll
                    for (int n = 0; n < 2; ++n) acc[a][b][m][n] = (f32x4){0.f, 0.f, 0.f, 0.f};
        cur = nxt; cA = nA; cB = nB; ++ui;
    }
    PG8_WAIT_V(0);
    if (wr == 0) PG8_BAR;
    PG8_BAR;
#undef PG8_SA
#undef PG8_SB
#undef PG8_STAGE
#undef PG8_LDA
#undef PG8_LDB
#undef PG8_MMA
#undef PG8_WAIT_V
#undef PG8_WAIT_L
#undef PG8_BAR
#undef PG8_SCHED
#undef PG8_ABASE
#undef PG8_BBASE
}
}
using pg8::Unit; using pg8::Gemm; using pg8::Sched;
typedef const f32x4 (&AccRef)[2][2][4][2];

struct EpiFFNup {
    static constexpr bool AGROUP = false;
    static constexpr bool F16 = true;
    static constexpr bool PERM = true; const float* part; bf16_t* G;
    __device__ __forceinline__ void operator()(AccRef acc, const Unit& u, int wr, int wc, int fr, int fq) const {
        const int row0 = u.pm * 256 + wr * 64 + fr, col0 = u.pn * 128 + wc * 32 + 8 * fq;
#pragma unroll
        for (int ai = 0; ai < 2; ++ai)
#pragma unroll
            for (int m = 0; m < 4; ++m) { const int row = row0 + ai * 128 + m * 16; const float rs = rowscale4(part, row, fq); float o[8];
#pragma unroll
                for (int n = 0; n < 2; ++n)
#pragma unroll
                    for (int j = 0; j < 4; ++j) { const float gt = acc[ai][0][m][n][j] * rs, up = acc[ai][1][m][n][j] * rs; o[4 * n + j] = gt * sigmoidf_(gt) * up; }
                *(u32x4*)(G + (size_t)row * DFF + col0) = pack8(o); }
    }
};
struct EpiResid {
    static constexpr bool AGROUP = false;
    static constexpr bool F16 = false;
    static constexpr bool PERM = false; float* out; bf16_t* xb; float* part; float alpha;
    __device__ __forceinline__ void operator()(AccRef acc, const Unit& u, int wr, int wc, int fr, int fq) const {
        const int row0 = u.pm * 256 + wr * 64 + fr, col0 = u.pn * 256 + wc * 32 + 4 * fq;
        const bf16_t* __restrict__ xin = xb; bf16_t* __restrict__ xo_ = xb;
#pragma unroll
        for (int ai = 0; ai < 2; ++ai) {
            u32x2 xv0[4][2][2];
#pragma unroll
            for (int m = 0; m < 4; ++m)
#pragma unroll
                for (int bj = 0; bj < 2; ++bj)
#pragma unroll
                    for (int n = 0; n < 2; ++n) xv0[m][bj][n] = *(const u32x2*)(xin + (size_t)(row0 + ai * 128 + m * 16) * DM + col0 + bj * 128 + n * 16);
#pragma unroll
            for (int m = 0; m < 4; ++m) { const int row = row0 + ai * 128 + m * 16; float ss = 0.f;
#pragma unroll
                for (int bj = 0; bj < 2; ++bj)
#pragma unroll
                    for (int n = 0; n < 2; ++n) { const size_t o = (size_t)row * DM + col0 + bj * 128 + n * 16; const u32x2 xo = xv0[m][bj][n];
                        const f32x2 x01 = unpk_f16(xo.x), x23 = unpk_f16(xo.y); f32x4 xv = (f32x4){x01.x, x01.y, x23.x, x23.y};
                        xv += alpha * acc[ai][bj][m][n];
                        if (out) *(f32x4*)(out + o) = xv;
                        ss += (xv[0] * xv[0] + xv[1] * xv[1]) + (xv[2] * xv[2] + xv[3] * xv[3]);
                        u32x2 w; w.x = cvt_pk_f16(xv[0], xv[1]); w.y = cvt_pk_f16(xv[2], xv[3]); *(u32x2*)(xo_ + o) = w; }
                ss += __shfl_xor(ss, 16); ss += __shfl_xor(ss, 32);
                if (fq == 0) part[(size_t)row * 16 + u.pn * 4 + wc] = ss; }
        }
    }
};
__device__ __forceinline__ void head_norm_rope(float (&v)[2][8], const float* gain, const unsigned char* ws, unsigned rope_off, int fq, float scale) {
    float ss = 0.f;
#pragma unroll
    for (int bj = 0; bj < 2; ++bj)
#pragma unroll
        for (int e = 0; e < 8; ++e) ss += v[bj][e] * v[bj][e];
    ss += __shfl_xor(ss, 16); ss += __shfl_xor(ss, 32);
    const float inv = rsqrtf(ss * (1.0f / 64.0f) + EPS);
#pragma unroll
    for (int e4 = 0; e4 < 2; ++e4) {
        const f32x4 ga = *(const f32x4*)(gain + 8 * fq + 4 * e4), gb = *(const f32x4*)(gain + 32 + 8 * fq + 4 * e4);
        const f32x4 c01 = *(const f32x4*)(ws + rope_off + (unsigned)(8 * fq + 4 * e4) * 8u), c23 = *(const f32x4*)(ws + rope_off + (unsigned)(8 * fq + 4 * e4 + 2) * 8u);
        const float cs[4] = {c01[0], c01[2], c23[0], c23[2]}, sn[4] = {c01[1], c01[3], c23[1], c23[3]};
#pragma unroll
        for (int j = 0; j < 4; ++j) { const int e = 4 * e4 + j; const float x1 = v[0][e] * inv * ga[j], x2 = v[1][e] * inv * gb[j];
            v[0][e] = (x1 * cs[j] - x2 * sn[j]) * scale; v[1][e] = (x2 * cs[j] + x1 * sn[j]) * scale; }
    }
}
struct EpiWin {
    static constexpr bool AGROUP = false;
    static constexpr bool F16 = true;
    static constexpr bool PERM = true;
    const float* q_norm; const float* k_norm; unsigned char* ws;
    __device__ __forceinline__ void operator()(AccRef acc, const Unit& u, int wr, int wc, int fr, int fq) const {
        const int row0 = u.pm * 256 + wr * 64 + fr; const int pn = win_role(u.pn);
#pragma unroll
        for (int am = 0; am < 4; ++am) { const int ai = am >> 1;
            float rsv[2];
#pragma unroll
            for (int m2 = 0; m2 < 2; ++m2) rsv[m2] = rowscale4((const float*)(ws + (unsigned)OFF_PART), row0 + ai * 128 + ((am & 1) * 2 + m2) * 16, fq);
#pragma unroll
            for (int m2 = 0; m2 < 2; ++m2) { const int m = (am & 1) * 2 + m2;
                const unsigned row = (unsigned)(row0 + ai * 128 + m * 16);
                const float rs = rsv[m2]; const unsigned b = row >> 12, s = row & 4095u;
                float v[2][8];
#pragma unroll
                for (int bj = 0; bj < 2; ++bj)
#pragma unroll
                    for (int n = 0; n < 2; ++n)
#pragma unroll
                        for (int j = 0; j < 4; ++j) v[bj][4 * n + j] = acc[ai][bj][m][n][j] * rs;
                if (pn < 2) {
#pragma unroll
                    for (int bj = 0; bj < 2; ++bj) { const unsigned lc = 256u * pn + 64u * wc + 32u * bj + 8u * fq; const unsigned g = lc >> 4, c0 = lc & 15u;
                        *(u32x4*)(ws + (unsigned)OFF_AG + ((g * 512u + (row >> 5)) * 640u + (row & 31u) * 16u + c0) * 2u) = pack8(v[bj]); }
                } else if (pn < 4) {
                    const unsigned h = (unsigned)(pn - 2) * 4u + wc;
                    head_norm_rope(v, q_norm, ws, (unsigned)OFF_ROPE + s * 256u, fq, QSCALE);
                    const unsigned o = (unsigned)OFF_QN + ((((b * 2u + (h >> 2)) * 4096u + s) * 4u + (h & 3u)) * 64u + 8u * fq) * 2u;
                    *(u32x4*)(ws + o) = pack8(v[0]); *(u32x4*)(ws + o + 64u) = pack8(v[1]);
                } else if (pn == 4) {
                    const unsigned g = wc & 1; const unsigned o = (unsigned)(wc < 2 ? OFF_KCR : OFF_VCR) + (((b * 2u + g) * 4096u + s) * 64u + 8u * fq) * 2u;
                    *(u32x4*)(ws + o) = pack8(v[0]); *(u32x4*)(ws + o + 64u) = pack8(v[1]);
                } else if (pn < 7) {
                    const unsigned g = wc & 1;
                    if (wc < 2) {
                        head_norm_rope(v, k_norm + (pn == 5 ? 64 : 128), ws, (unsigned)OFF_ROPE + s * 256u, fq, 1.0f);
                        const unsigned o = (unsigned)(pn == 5 ? OFF_KSEL : OFF_KWIN) + (((b * 2u + g) * 4096u + s) * 64u + 8u * fq) * 2u;
                        *(u32x4*)(ws + o) = pack8(v[0]); *(u32x4*)(ws + o + 64u) = pack8(v[1]);
                    } else {
                        const unsigned o = (unsigned)(pn == 5 ? OFF_VSELT : OFF_VWINT) + (((b * 2u + g) * 4096u + s) * 64u + 8u * fq) * 2u;
                        *(u32x4*)(ws + o) = pack8(v[0]); *(u32x4*)(ws + o + 64u) = pack8(v[1]);
                    }
                } else if (pn < 15) {
                    const unsigned t = (unsigned)(pn - 7) & 3u; const unsigned o = (unsigned)(pn < 11 ? OFF_GA : OFF_GB) + (row * 1024u + 256u * t + 64u * wc + 8u * fq) * 2u;
#pragma unroll
                    for (int bj = 0; bj < 2; ++bj) { float oo[8];
#pragma unroll
                        for (int e = 0; e < 8; ++e) oo[e] = sigmoidf_(v[bj][e]);
                        *(u32x4*)(ws + o + 64u * bj) = pack8(oo); }
                } else {
                    if (wc == 0 && fq < 3) { const unsigned o = (unsigned)OFF_NGATE + (row * 24u + 8u * fq) * 4u;
                        f32x4 a, c;
#pragma unroll
                        for (int e = 0; e < 4; ++e) { a[e] = sigmoidf_(v[0][e]); c[e] = sigmoidf_(v[0][4 + e]); }
                        *(f32x4*)(ws + o) = a; *(f32x4*)(ws + o + 16u) = c; }
                }
            }
        }
    }
};
struct EpiS5A {
    static constexpr bool AGROUP = false;
    static constexpr bool F16 = false;
    static constexpr bool PERM = false; float* E;
    __device__ __forceinline__ void operator()(AccRef acc, const Unit& u, int wr, int wc, int fr, int fq) const {
        const int row0 = u.pm * 256 + wr * 64 + fr, col0 = wc * 32 + 4 * fq;
#pragma unroll
        for (int ai = 0; ai < 2; ++ai)
#pragma unroll
            for (int m = 0; m < 4; ++m) { const int row = row0 + ai * 128 + m * 16;
#pragma unroll
                for (int n = 0; n < 2; ++n) *(f32x4*)(E + ((size_t)u.z * 512 + row) * 128 + col0 + n * 16) = acc[ai][0][m][n]; }
    }
};
struct EpiS5C {
    static constexpr bool AGROUP = false;
    static constexpr bool F16 = false;
    static constexpr bool PERM = true; bf16_t* y;
    __device__ __forceinline__ void operator()(AccRef acc, const Unit& u, int wr, int wc, int fr, int fq) const {
        const int row0 = u.pm * 256 + wr * 64 + fr;
#pragma unroll
        for (int ai = 0; ai < 2; ++ai)
#pragma unroll
            for (int m = 0; m < 4; ++m) { const int row = row0 + ai * 128 + m * 16;
#pragma unroll
                for (int bj = 0; bj < 2; ++bj) { const int col = 256 * u.pn + 128 * bj + 32 * wc + 8 * fq; const int i = col >> 4, c0 = col & 15; float o[8];
#pragma unroll
                    for (int n = 0; n < 2; ++n)
#pragma unroll
                        for (int j = 0; j < 4; ++j) o[4 * n + j] = gelu_tanh(acc[ai][bj][m][n][j]);
                    *(u32x4*)(y + (size_t)u.z * pg8::AGS + ((size_t)row * 32 + i) * 16 + c0) = pack8(o); } }
    }
};
struct EpiGLU {
    static constexpr bool AGROUP = true;
    static constexpr bool F16 = false;
    static constexpr bool PERM = true; bf16_t* ga;
    __device__ __forceinline__ void operator()(AccRef acc, const Unit& u, int wr, int wc, int fr, int fq) const {
        const int row0 = u.pm * 256 + wr * 64 + fr, col0 = u.pn * 128 + wc * 32 + 8 * fq;
        const bf16_t* __restrict__ gin = ga; bf16_t* __restrict__ gout = ga;
        u32x4 gv[2][4];
#pragma unroll
        for (int ai = 0; ai < 2; ++ai)
#pragma unroll
            for (int m = 0; m < 4; ++m) gv[ai][m] = *(const u32x4*)(gin + (size_t)(row0 + ai * 128 + m * 16) * 1024 + col0);
#pragma unroll
        for (int ai = 0; ai < 2; ++ai)
#pragma unroll
            for (int m = 0; m < 4; ++m) { const int row = row0 + ai * 128 + m * 16; float o[8];
#pragma unroll
                for (int n = 0; n < 2; ++n)
#pragma unroll
                    for (int j = 0; j < 4; ++j) { const int e = 4 * n + j; const unsigned w = gv[ai][m][e >> 1]; const float gaf = __uint_as_float((e & 1) ? (w & 0xffff0000u) : (w << 16));
                        o[e] = gaf * acc[ai][0][m][n][j] * sigmoidf_(acc[ai][1][m][n][j]); }
                *(u32x4*)(gout + (size_t)row * 1024 + col0) = pack8(o); }
    }
};
struct EpiUp {
    static constexpr bool AGROUP = false;
    static constexpr bool F16 = false;
    static constexpr bool PERM = true; bf16_t* mg; const bf16_t* gb;
    __device__ __forceinline__ void operator()(AccRef acc, const Unit& u, int wr, int wc, int fr, int fq) const {
        const int row0 = u.pm * 256 + wr * 64 + fr;
        const bf16_t* __restrict__ min_ = mg; bf16_t* __restrict__ mout = mg; const bf16_t* __restrict__ gbr = gb;
#pragma unroll
        for (int ai = 0; ai < 2; ++ai)
#pragma unroll
          for (int mh = 0; mh < 2; ++mh) {
            u32x4 mv[2][2], gv[2][2];
#pragma unroll
            for (int m2 = 0; m2 < 2; ++m2)
#pragma unroll
                for (int bj = 0; bj < 2; ++bj) { const size_t o = (size_t)(row0 + ai * 128 + (2 * mh + m2) * 16) * 1024 + 256 * u.pn + 128 * bj + 32 * wc + 8 * fq; mv[m2][bj] = *(const u32x4*)(min_ + o); gv[m2][bj] = *(const u32x4*)(gbr + o); }
#pragma unroll
            for (int m2 = 0; m2 < 2; ++m2)
#pragma unroll
                for (int bj = 0; bj < 2; ++bj) { const int m = 2 * mh + m2; const size_t o = (size_t)(row0 + ai * 128 + m * 16) * 1024 + 256 * u.pn + 128 * bj + 32 * wc + 8 * fq; float r[8];
#pragma unroll
                    for (int n = 0; n < 2; ++n)
#pragma unroll
                        for (int j = 0; j < 4; ++j) { const int e = 4 * n + j; const unsigned wm = mv[m2][bj][e >> 1], wg = gv[m2][bj][e >> 1];
                            const float mf = __uint_as_float((e & 1) ? (wm & 0xffff0000u) : (wm << 16)), gf = __uint_as_float((e & 1) ? (wg & 0xffff0000u) : (wg << 16));
                            r[e] = mf + gf * acc[ai][bj][m][n][j]; }
                    *(u32x4*)(mout + o) = pack8(r); }
          }
    }
};
struct EpiCmp1 {
    static constexpr bool AGROUP = false;
    static constexpr bool F16 = false;
    static constexpr bool PERM = false; float* cp;
    __device__ __forceinline__ void operator()(AccRef acc, const Unit& u, int wr, int wc, int fr, int fq) const {
        const int row0 = u.pm * 256 + wr * 64 + fr, col0 = wc * 32 + 4 * fq;
#pragma unroll
        for (int ai = 0; ai < 2; ++ai)
#pragma unroll
            for (int m = 0; m < 4; ++m) { const int row = row0 + ai * 128 + m * 16;
#pragma unroll
                for (int n = 0; n < 2; ++n) *(f32x4*)(cp + ((size_t)u.z * 2048 + row) * 128 + col0 + n * 16) = acc[ai][0][m][n]; }
    }
};

struct ConvTile { const float* src; const float* gain; bf16_t* dst; int srcN, K, base, valid, p, k0, f16; };
__device__ __forceinline__ ConvTile conv_decode(const Params& P, int l, int job) {
    unsigned char* ws = P.ws + ((l & 1) ? OFF_WALT : 0);
    const int ntile[10] = {704, 352, 704, 352, 512, 128, 64, 128, 32, 32};
    int mi = 0, t = job;
    while (mi < 9 && t >= ntile[mi]) { t -= ntile[mi]; ++mi; }
    ConvTile c; c.gain = nullptr; int kind = 0, half = 0; c.f16 = (mi == 0 || mi == 2 || mi == 4) ? 1 : 0;
    switch (mi) {
        case 0: c.src = P.ffn1_wi + (size_t)l * 1024 * 5632; c.gain = P.norm_ffn1 + l * 1024; c.dst = (bf16_t*)(ws + OFF_WI1); c.srcN = 5632; c.K = 1024; kind = 1; half = 2816; break;
        case 1: c.src = P.ffn1_wo + (size_t)l * 2816 * 1024; c.dst = (bf16_t*)(ws + OFF_WO1); c.srcN = 1024; c.K = 2816; break;
        case 2: c.src = P.ffn2_wi + (size_t)l * 1024 * 5632; c.gain = P.norm_ffn2 + l * 1024; c.dst = (bf16_t*)(ws + OFF_WI2); c.srcN = 5632; c.K = 1024; kind = 1; half = 2816; break;
        case 3: c.src = P.ffn2_wo + (size_t)l * 2816 * 1024; c.dst = (bf16_t*)(ws + OFF_WO2); c.srcN = 1024; c.K = 2816; break;
        case 4: c.src = P.w_in + (size_t)l * 1024 * 3864; c.gain = P.norm_mix + l * 1024; c.dst = (bf16_t*)(ws + OFF_WIN); c.srcN = 3864; c.K = 1024; kind = 3; break;
        case 5: c.src = P.w_glu + (size_t)l * 512 * 2048; c.dst = (bf16_t*)(ws + OFF_WGLU); c.srcN = 2048; c.K = 512; kind = 1; half = 1024; break;
        case 6: c.src = P.w_up + (size_t)l * 512 * 1024; c.dst = (bf16_t*)(ws + OFF_WUP); c.srcN = 1024; c.K = 512; break;
        case 7: c.src = P.w_out + (size_t)l * 1024 * 1024; c.dst = (bf16_t*)(ws + OFF_WOUT); c.srcN = 1024; c.K = 1024; break;
        case 8: c.src = P.cmp_w1 + ((size_t)l * 2 + 0) * 2048 * 128; c.dst = (bf16_t*)(ws + OFF_CW1); c.srcN = 128; c.K = 2048; break;
        default: c.src = P.cmp_w1 + ((size_t)l * 2 + 1) * 2048 * 128; c.dst = (bf16_t*)(ws + OFF_CW1) + 256 * 2048; c.srcN = 128; c.K = 2048; break;
    }
    const int nkt = c.K >> 8; const int q = t / nkt, kt = t % nkt; c.k0 = kt * 256; const int p = q * 32; c.p = p; c.valid = 32;
    if (kind == 0) c.base = p;
    else if (kind == 1) { const int pn = p >> 8, bj = (p >> 7) & 1, xx = p & 127; c.base = bj * half + pn * 128 + xx; }
    else { const int pn = win_role(p >> 8), pp = p & 255; const int lc = 64 * ((pp >> 5) & 3) + 32 * (pp >> 7); const int LC = 256 * pn + lc;
        if (LC < 1792) c.base = LC; else if (LC < 3840) c.base = LC + 24; else if (LC == 3840) { c.base = 1792; c.valid = 24; } else { c.base = 0; c.valid = 0; } }
    return c;
}
__device__ __forceinline__ void conv_load(const ConvTile& c, float (&v)[16], int tid) {
    const int col = tid & 31;
#pragma unroll
    for (int it = 0; it < 16; ++it) { const int k = it * 16 + (tid >> 5); v[it] = col < c.valid ? c.src[(size_t)(c.k0 + k) * c.srcN + c.base + col] : 0.f; }
    if (c.gain) {
#pragma unroll
        for (int it = 0; it < 16; ++it) v[it] *= c.gain[c.k0 + it * 16 + (tid >> 5)]; }
}
__device__ __forceinline__ void conv_store(const ConvTile& c, const float (&v)[16], LAS float* T, int tid) {
    const int col = tid & 31;
#pragma unroll
    for (int it = 0; it < 16; ++it) T[(it * 16 + (tid >> 5)) * 33 + col] = v[it];
    __syncthreads();
#pragma unroll
    for (int it = 0; it < 8; ++it) { const int r = it * 4 + (tid >> 7), kk = (tid & 127) * 2;
        const float a0 = T[kk * 33 + r], a1 = T[(kk + 1) * 33 + r];
        *(unsigned*)(c.dst + (size_t)(c.p + r) * c.K + c.k0 + kk) = c.f16 ? cvt_pk_f16(a0, a1) : cvt_pk_bf16(a0, a1); }
    __syncthreads();
}
__device__ __forceinline__ void prep_jobs(const Params& P, int l, LAS unsigned char* lds, int j0, int j1, int wi, int wn) {
    const int tid = opaque_tid();
    int job = j0 + wi;
    if (wi < 0 || job >= j1) return;
    ConvTile cur = conv_decode(P, l, job); float v[16]; conv_load(cur, v, tid);
    for (;;) {
        const int nj = job + wn; const bool more = nj < j1; ConvTile nxt = cur; float w[16];
        if (more) { nxt = conv_decode(P, l, nj); conv_load(nxt, w, tid); }
        conv_store(cur, v, (LAS float*)lds, tid);
        if (!more) break;
#pragma unroll
        for (int it = 0; it < 16; ++it) v[it] = w[it];
        cur = nxt; job = nj;
    }
}

__device__ __forceinline__ void phase_init_a(const Params& P, LAS unsigned char* lds) {
    unsigned char* ws = P.ws; const int tid = opaque_tid(), lane = tid & 63, wave = tid >> 6;
    for (int job = opaque_bid(); job < 2048 + 256 + 544 + 16; job += gridDim.x) {
        if (job >= 2048 + 256 + 544) {
            const int jj = job - (2048 + 256 + 544); const int lz = jj >> 1, h = (jj & 1) * 64 + lane; LAS float* red = (LAS float*)lds;
            const float* pe = P.cmp_pe + (size_t)lz * 2048 + wave * 256; const float* w1 = P.cmp_w1 + ((size_t)lz * 2048 + wave * 256) * 128 + h; float s0 = 0.f, s1 = 0.f, s2 = 0.f, s3 = 0.f;
            for (int k = 0; k < 256; k += 4) { s0 += pe[k] * w1[(size_t)k * 128]; s1 += pe[k + 1] * w1[(size_t)(k + 1) * 128]; s2 += pe[k + 2] * w1[(size_t)(k + 2) * 128]; s3 += pe[k + 3] * w1[(size_t)(k + 3) * 128]; }
            __syncthreads(); red[wave * 64 + lane] = (s0 + s1) + (s2 + s3); __syncthreads();
            if (wave == 0) { float t = 0.f; for (int w = 0; w < 8; ++w) t += red[w * 64 + lane]; ((float*)(ws + OFF_CBIAS))[lz * 128 + h] = t; }
            continue;
        }
        if (job < 2048) {
            const int row = job * 8 + wave; float ss = 0.f;
#pragma unroll
            for (int k = 0; k < 4; ++k) { const size_t o = (size_t)row * 1024 + k * 256 + lane * 4; const f32x4 v = *(const f32x4*)(P.x + o);
                ss += (v[0] * v[0] + v[1] * v[1]) + (v[2] * v[2] + v[3] * v[3]); u32x2 w; w.x = cvt_pk_f16(v[0], v[1]); w.y = cvt_pk_f16(v[2], v[3]); *(u32x2*)((bf16_t*)(ws + OFF_XB) + o) = w; }
#pragma unroll
            for (int sft = 32; sft >= 1; sft >>= 1) ss += __shfl_xor(ss, sft);
            if (lane < 16) ((float*)(ws + OFF_PART))[(size_t)row * 16 + lane] = lane == 0 ? ss : 0.f;
        } else if (job < 2048 + 256) {
            const int idx = (job - 2048) * 512 + tid; const int pos = idx >> 5, i = idx & 31;
            const float inv_freq = 1.0f / powf(10000.0f, (float)i / 32.0f); const float ang = (float)pos * inv_freq;
            f32x2 cs; cs.x = (float)cos((double)ang); cs.y = (float)sin((double)ang); ((f32x2*)(ws + OFF_ROPE))[idx] = cs;
        } else {
            const int e = (job - 2048 - 256) * 512 + tid; const int idx = e / 34, tau = e - idx * 34, lg = idx >> 6;
            const float dt = expf(P.log_dt[lg]); const float lr = P.lam_re[idx], li = P.lam_im[idx];
            const int tt = tau == 33 ? 1 : tau;
            const float mg = expf(lr * dt * (float)tt), an = li * dt * (float)tt; const float ar = mg * cosf(an), aim = mg * sinf(an);
            if (tau != 33) { f32x2 v; v.x = ar; v.y = aim; ((f32x2*)(ws + OFF_POW))[e] = v; }
            else {
                const float inv = 1.0f / (lr * lr + li * li); const float nr = ar - 1.0f, ni = aim;
                const float fr_ = (nr * lr + ni * li) * inv, fi_ = (ni * lr - nr * li) * inv;
                f32x4 br4[4], bi4[4];
#pragma unroll
                for (int q = 0; q < 4; ++q) { br4[q] = *(const f32x4*)(P.b_re + (size_t)idx * 16 + 4 * q); bi4[q] = *(const f32x4*)(P.b_im + (size_t)idx * 16 + 4 * q); }
                f32x4* bb = (f32x4*)(ws + OFF_BBAR) + (size_t)idx * 8;
#pragma unroll
                for (int q = 0; q < 4; ++q)
#pragma unroll
                    for (int h2 = 0; h2 < 2; ++h2) { const float b0r = br4[q][2 * h2], b0i = bi4[q][2 * h2], b1r = br4[q][2 * h2 + 1], b1i = bi4[q][2 * h2 + 1];
                        bb[2 * q + h2] = (f32x4){fr_ * b0r - fi_ * b0i, fr_ * b0i + fi_ * b0r, fr_ * b1r - fi_ * b1i, fr_ * b1i + fi_ * b1r}; }
            }
        }
    }
}
__device__ __forceinline__ void phase_init_b(const Params& P, LAS unsigned char* lds) {
    unsigned char* ws = P.ws; const int tid = opaque_tid();
    const f32x2* POW = (const f32x2*)(ws + OFF_POW); const f32x2* BB = (const f32x2*)(ws + OFF_BBAR);
    const int Gb = gridDim.x, cb = opaque_bid(); const bool bal = Gb == 256;
    for (int kb = 0; ; ++kb) {
        int job;
        if (bal) { if (cb < 128) { if (kb > 2) break; job = kb == 0 ? cb : 128 + cb + 128 * (kb - 1); } else { if (kb > 5) break; job = 384 + (cb - 128) + 128 * kb; } }
        else { job = cb + kb * Gb; if (job >= 128 + 512 + 512) break; }
        if (job < 128) {
            const int lg = job; const int c = tid & 15, tau = tid >> 4;
            LAS f32x2* BBs = (LAS f32x2*)lds; LAS float* Crs = (LAS float*)(lds + 8192); LAS float* Cis = (LAS float*)(lds + 12288); LAS f32x2* PWs = (LAS f32x2*)(lds + 16384);
            __syncthreads();
            { const f32x2 b0 = BB[(size_t)lg * 1024 + tid], b1 = BB[(size_t)lg * 1024 + 512 + tid];
              const float r0 = P.c_re[(size_t)lg * 1024 + tid], r1 = P.c_re[(size_t)lg * 1024 + 512 + tid], i0 = P.c_im[(size_t)lg * 1024 + tid], i1 = P.c_im[(size_t)lg * 1024 + 512 + tid];
              f32x2 pv[5];
#pragma unroll
              for (int q = 0; q < 5; ++q) { const int o = tid + 512 * q; pv[q] = o < 2176 ? POW[(size_t)lg * 2176 + o] : (f32x2){0.f, 0.f}; }
              BBs[tid] = b0; BBs[512 + tid] = b1; Crs[tid] = r0; Crs[512 + tid] = r1; Cis[tid] = i0; Cis[512 + tid] = i1;
#pragma unroll
              for (int q = 0; q < 5; ++q) { const int o = tid + 512 * q; if (o < 2176) PWs[o] = pv[q]; } }
            __syncthreads();
            float acc[16];
#pragma unroll
            for (int q = 0; q < 16; ++q) acc[q] = 0.f;
#pragma unroll 4
            for (int n = 0; n < 64; ++n) { const float cr = Crs[c * 64 + n], ci = Cis[c * 64 + n];
                const f32x2 pw = PWs[n * 34 + tau]; const float wr_ = cr * pw.x - ci * pw.y, wi_ = cr * pw.y + ci * pw.x; const LAS f32x4* bb = (const LAS f32x4*)(BBs + n * 16);
#pragma unroll
                for (int q = 0; q < 8; ++q) { const f32x4 v = bb[q]; acc[2 * q] += wr_ * v[0] - wi_ * v[1]; acc[2 * q + 1] += wr_ * v[2] - wi_ * v[3]; } }
            { const float dsk = tau == 0 ? P.ssm_d[(size_t)lg * 16 + c] : 0.f;
#pragma unroll
              for (int q = 0; q < 16; ++q) acc[q] += (q == c) ? dsk : 0.f; }
            float* dst = (float*)(ws + OFF_KG) + ((size_t)lg * 512 + tid) * 16;
#pragma unroll
            for (int q = 0; q < 4; ++q) *(f32x4*)(dst + 4 * q) = (f32x4){acc[4 * q], acc[4 * q + 1], acc[4 * q + 2], acc[4 * q + 3]};
        } else if (job < 128 + 512) {
            f32x2 pwv[4]; f32x4 bbv[4][4];
#pragma unroll
            for (int u = 0; u < 4; ++u) { const int e = ((job - 128) * 4 + u) * 512 + tid; const int k8 = e & 63, nn = (e >> 6) & 127, lg = e >> 13; const int n = nn >> 1, k0 = k8 * 8, j = k0 >> 4, cp0 = k0 & 15;
                const size_t sn = (size_t)lg * 64 + n; pwv[u] = POW[sn * 34 + (31 - j)];
#pragma unroll
                for (int q = 0; q < 4; ++q) bbv[u][q] = *(const f32x4*)(BB + sn * 16 + cp0 + 2 * q); }
#pragma unroll
            for (int u = 0; u < 4; ++u) { const int e = ((job - 128) * 4 + u) * 512 + tid; const int k8 = e & 63, nn = (e >> 6) & 127, lg = e >> 13; const int ri = nn & 1, k0 = k8 * 8; const f32x2 pw = pwv[u]; float o[8];
#pragma unroll
                for (int q = 0; q < 4; ++q) { const f32x4 v = bbv[u][q];
                    o[2 * q] = ri ? (pw.x * v[1] + pw.y * v[0]) : (pw.x * v[0] - pw.y * v[1]); o[2 * q + 1] = ri ? (pw.x * v[3] + pw.y * v[2]) : (pw.x * v[2] - pw.y * v[3]); }
                *(u32x4*)((bf16_t*)(ws + OFF_PT) + ((size_t)lg * 128 + nn) * 512 + k0) = pack8(o); }
        } else {
            f32x4 crv[4], civ[4]; f32x2 pwq[4][4];
#pragma unroll
            for (int u = 0; u < 4; ++u) { const int e = ((job - 128 - 512) * 4 + u) * 512 + tid; const int n4 = e & 15, ic = (e >> 4) & 511, lg = e >> 13; const int n0 = n4 * 4, i = ic >> 4, c = ic & 15;
                crv[u] = *(const f32x4*)(P.c_re + ((size_t)lg * 16 + c) * 64 + n0); civ[u] = *(const f32x4*)(P.c_im + ((size_t)lg * 16 + c) * 64 + n0);
#pragma unroll
                for (int q = 0; q < 4; ++q) pwq[u][q] = POW[((size_t)lg * 64 + n0 + q) * 34 + i + 1]; }
#pragma unroll
            for (int u = 0; u < 4; ++u) { const int e = ((job - 128 - 512) * 4 + u) * 512 + tid; const int n4 = e & 15, ic = (e >> 4) & 511, lg = e >> 13; const int n0 = n4 * 4; float o[8];
#pragma unroll
                for (int q = 0; q < 4; ++q) { const f32x2 pw = pwq[u][q]; o[2 * q] = crv[u][q] * pw.x - civ[u][q] * pw.y; o[2 * q + 1] = -(crv[u][q] * pw.y + civ[u][q] * pw.x); }
                *(u32x4*)((bf16_t*)(ws + OFF_TQ) + ((size_t)lg * 512 + ic) * 640 + 512 + 2 * n0) = pack8(o); }
        }
    }
}
__device__ __forceinline__ void phase_init_c(const Params& P) {
    unsigned char* ws = P.ws; const int tid = opaque_tid(); const float* KG = (const float*)(ws + OFF_KG);
    for (int job = opaque_bid(); job < 8192; job += gridDim.x) {
        const int e = job * 512 + tid; const int k8 = e & 63, ic = (e >> 6) & 511, lg = e >> 15; const int k0 = k8 * 8, j = k0 >> 4, c0 = k0 & 15, i = ic >> 4, c = ic & 15;
        u32x4 w = (u32x4){0u, 0u, 0u, 0u};
        if (j <= i) { const float* src = KG + ((size_t)lg * 32 + (i - j)) * 256 + c * 16 + c0; const f32x4 a = *(const f32x4*)src, b = *(const f32x4*)(src + 4);
            w.x = cvt_pk_bf16(a[0], a[1]); w.y = cvt_pk_bf16(a[2], a[3]); w.z = cvt_pk_bf16(b[0], b[1]); w.w = cvt_pk_bf16(b[2], b[3]); }
        *(u32x4*)((bf16_t*)(ws + OFF_TQ) + ((size_t)lg * 512 + ic) * 640 + k0) = w;
    }
}

__device__ __forceinline__ void phase_p5(const Params& P, int l, LAS unsigned char* lds) {
    unsigned char* ws = P.ws; const int tid = opaque_tid(), lane = tid & 63, wave = tid >> 6;
    for (int job = opaque_bid(); job < 128 + 512; job += gridDim.x) {
        if (job < 128) {
            const int g = job >> 2, b = job & 3, n = lane, seg = wave; LAS f32x2* Ls = (LAS f32x2*)lds;
            const f32x2 a32 = ((const f32x2*)(ws + OFF_POW))[(((size_t)l * 32 + g) * 64 + n) * 34 + 32];
            const float* E = (const float*)(ws + OFF_E) + ((size_t)g * 512 + b * 128 + seg * 16) * 128 + 2 * n;
            bf16_t* Ag = (bf16_t*)(ws + OFF_AG) + ((size_t)g * 512 + b * 128 + seg * 16) * 640 + 512 + 2 * n;
            f32x2 ev[16];
#pragma unroll
            for (int i = 0; i < 16; ++i) ev[i] = *(const f32x2*)(E + (size_t)i * 128);
            float sr = 0.f, si = 0.f;
#pragma unroll
            for (int i = 0; i < 16; ++i) { const float nr = a32.x * sr - a32.y * si + ev[i].x, ni = a32.x * si + a32.y * sr + ev[i].y; sr = nr; si = ni; }
            __syncthreads();
            Ls[seg * 64 + n] = (f32x2){sr, si};
            float pr = a32.x, pi = a32.y;
#pragma unroll
            for (int q = 0; q < 4; ++q) { const float tr = pr * pr - pi * pi, ti = 2.f * pr * pi; pr = tr; pi = ti; }
            __syncthreads();
            sr = 0.f; si = 0.f;
            for (int s2 = 0; s2 < seg; ++s2) { const f32x2 L = Ls[s2 * 64 + n]; const float nr = pr * sr - pi * si + L.x, ni = pr * si + pi * sr + L.y; sr = nr; si = ni; }
#pragma unroll
            for (int i = 0; i < 16; ++i) { *(unsigned*)(Ag + (size_t)i * 640) = cvt_pk_bf16(sr, si);
                const float nr = a32.x * sr - a32.y * si + ev[i].x, ni = a32.x * si + a32.y * sr + ev[i].y; sr = nr; si = ni; }
        } else {
            const int j2 = job - 128; LAS float* Hs = (LAS float*)lds;
            const float* cp = (const float*)(ws + OFF_CPART); const float* cb = (const float*)(ws + OFF_CBIAS) + l * 256;
            __syncthreads();
            LAS float* W2s = (LAS float*)(lds + 4096);
            { const int zj = (j2 * 8) >> 11; const float* w2g = P.cmp_w2 + ((size_t)l * 2 + zj) * 128 * 64; float wv[16];
#pragma unroll
              for (int q = 0; q < 16; ++q) wv[q] = w2g[tid + 512 * q];
#pragma unroll
              for (int q = 0; q < 16; ++q) W2s[tid + 512 * q] = wv[q]; }
            { float pv[2][9];
#pragma unroll
              for (int h2 = 0; h2 < 2; ++h2) { const int id = tid + h2 * 512; const int rr = id >> 7, h = id & 127; const int R = j2 * 8 + rr; const int z = R >> 11, r = R & 2047;
                  pv[h2][8] = cb[z * 128 + h];
#pragma unroll
                  for (int sp = 0; sp < 8; ++sp) pv[h2][sp] = cp[(((size_t)z * 8 + sp) * 2048 + r) * 128 + h]; }
#pragma unroll
              for (int h2 = 0; h2 < 2; ++h2) { float s2 = pv[h2][8];
#pragma unroll
                  for (int sp = 0; sp < 8; ++sp) s2 += pv[h2][sp];
                  Hs[tid + h2 * 512] = gelu_tanh(s2); } }
            __syncthreads();
            const int R = j2 * 8 + wave; const int z = R >> 11, r = R & 2047; const int bg = r >> 8, n = r & 255;
            const float* w2 = P.cmp_w2 + ((size_t)l * 2 + z) * 128 * 64; float o = 0.f;
            { float o0 = 0.f, o1 = 0.f, o2 = 0.f, o3 = 0.f;
#pragma unroll 8
              for (int h = 0; h < 128; h += 4) { o0 += Hs[wave * 128 + h] * W2s[h * 64 + lane]; o1 += Hs[wave * 128 + h + 1] * W2s[(h + 1) * 64 + lane]; o2 += Hs[wave * 128 + h + 2] * W2s[(h + 2) * 64 + lane]; o3 += Hs[wave * 128 + h + 3] * W2s[(h + 3) * 64 + lane]; }
              o = (o0 + o1) + (o2 + o3); }
            if (z == 0) {
                float ss = o * o;
#pragma unroll
                for (int sft = 32; sft >= 1; sft >>= 1) ss += __shfl_xor(ss, sft);
                const float xn = o * rsqrtf(ss * (1.0f / 64.0f) + EPS) * P.k_norm[(size_t)l * 192 + lane];
                const float other = __shfl_xor(xn, 32); const int pos = 16 * n + 31; const int i = lane & 31;
                f32x2 cs = (f32x2){1.f, 0.f}; if (n < 255) cs = ((const f32x2*)(ws + OFF_ROPE))[(size_t)pos * 32 + i];
                float res = lane < 32 ? (xn * cs.x - other * cs.y) : (xn * cs.x + other * cs.y);
                if (n == 255) res = 0.f;
                ((bf16_t*)(ws + OFF_KCN))[((size_t)bg * 256 + n) * 64 + lane] = f2bf(res);
            } else {
                ((bf16_t*)(ws + OFF_VCT))[((size_t)bg * 64 + lane) * 256 + n] = f2bf(n == 255 ? 0.f : o);
            }
        }
    }
}

#define MFMA16(a, b, c) __builtin_amdgcn_mfma_f32_16x16x32_bf16((a), (b), (c), 0, 0, 0)
constexpr int ATT_KS = 0, ATT_VS = 18432, ATT_P = 36864;
constexpr float SOFF = 8.0f;
template <int MODE, bool Q0, bool Q1, int VSTR = 72>
__device__ __forceinline__ void tile_compute(const LAS bf16_t* Kb, const LAS bf16_t* Vb, const bf16x8 (&qf)[2][2], const int (&tq)[2], const float (&sinit)[2], bool boundary, int key0,
                                             f32x4 (&O)[2][4], float (&lrow)[2], int fr, int g4) {
    bf16x8 kf[4][2]; s16x4 vlo[2][4], vhi[2][4];
#pragma unroll
    for (int kt = 0; kt < 4; ++kt)
#pragma unroll
        for (int ks = 0; ks < 2; ++ks) kf[kt][ks] = *(const LAS bf16x8*)(Kb + (16 * kt + fr) * 72 + 32 * ks + 8 * g4);
    __builtin_amdgcn_sched_barrier(0);
    f32x4 S[2][4];
#pragma unroll
    for (int qi = 0; qi < 2; ++qi)
#pragma unroll
        for (int kt = 0; kt < 4; ++kt) S[qi][kt] = (f32x4){sinit[qi], sinit[qi], sinit[qi], sinit[qi]};
#pragma unroll
    for (int kt = 0; kt < 4; ++kt)
#pragma unroll
        for (int ks = 0; ks < 2; ++ks) { if (Q0) S[0][kt] = MFMA16(kf[kt][ks], qf[0][ks], S[0][kt]); if (Q1) S[1][kt] = MFMA16(kf[kt][ks], qf[1][ks], S[1][kt]); }
    __builtin_amdgcn_sched_barrier(0);
#pragma unroll
    for (int s2 = 0; s2 < 2; ++s2)
#pragma unroll
        for (int dt = 0; dt < 4; ++dt) { vlo[s2][dt] = *(const LAS s16x4*)(Vb + (16 * dt + fr) * VSTR + 32 * s2 + 4 * g4); vhi[s2][dt] = *(const LAS s16x4*)(Vb + (16 * dt + fr) * VSTR + 32 * s2 + 16 + 4 * g4); }
    __builtin_amdgcn_sched_barrier(0);
    bf16x8 pf[2][2];
#pragma unroll
    for (int qi = 0; qi < 2; ++qi) {
        if ((qi == 0 && Q0) || (qi == 1 && Q1)) {
            const int t = tq[qi]; float rs = 0.f;
#pragma unroll
            for (int kt = 0; kt < 4; ++kt)
#pragma unroll
                for (int j = 0; j < 4; ++j) { float p = fexp2(S[qi][kt][j]);
                    if (boundary) { const int key = key0 + 16 * kt + 4 * g4 + j; bool valid;
                        if (MODE == 0) valid = key <= t; else if (MODE == 1) valid = key <= t && (t - key) < 512; else valid = (16 * key + 31) <= t;
                        p = valid ? p : 0.f; }
                    S[qi][kt][j] = p; rs += p; }
            lrow[qi] += rs;
#pragma unroll
            for (int s2 = 0; s2 < 2; ++s2) { u32x4 w; w.x = cvt_pk_bf16(S[qi][2 * s2][0], S[qi][2 * s2][1]); w.y = cvt_pk_bf16(S[qi][2 * s2][2], S[qi][2 * s2][3]);
                w.z = cvt_pk_bf16(S[qi][2 * s2 + 1][0], S[qi][2 * s2 + 1][1]); w.w = cvt_pk_bf16(S[qi][2 * s2 + 1][2], S[qi][2 * s2 + 1][3]); pf[qi][s2] = __builtin_bit_cast(bf16x8, w); }
        }
    }
#pragma unroll
    for (int s2 = 0; s2 < 2; ++s2)
#pragma unroll
        for (int dt = 0; dt < 4; ++dt) { const bf16x8 vf = __builtin_shufflevector(vlo[s2][dt], vhi[s2][dt], 0, 1, 2, 3, 4, 5, 6, 7);
            if (Q0) O[0][dt] = MFMA16(vf, pf[0][s2], O[0][dt]);
            if (Q1) O[1][dt] = MFMA16(vf, pf[1][s2], O[1][dt]); }
}
template <int MODE>
__device__ __forceinline__ void flash_pass(LAS unsigned char* lds, const bf16_t* __restrict__ Kg, const bf16_t* __restrict__ Vg, int vstride, int tb, int te,
                                           const bf16x8 (&qf)[2][2], const int (&tq)[2], const unsigned long long (&sm)[2], f32x4 (&O)[2][4], float (&mrow)[2], float (&lrow)[2], int tid, int lane) {
    const int fr = lane & 15, g4 = lane >> 4; const int lr = tid >> 3, lch = tid & 7; const int vkey = tid & 63, vch = tid >> 6;
    LAS bf16_t* Ks = (LAS bf16_t*)(lds + ATT_KS); LAS bf16_t* Vs = (LAS bf16_t*)(lds + ATT_VS);
#define FP_LOADV(tile_) (MODE == 2 ? *(const u32x4*)(Vg + (size_t)lr * vstride + (tile_) * 64 + lch * 8) : *(const u32x4*)(Vg + (size_t)((tile_) * 64 + vkey) * 64 + vch * 8))
#define FP_STOREV(buf_, r_) do { LAS bf16_t* _vb = Vs + (buf_) * 64 * 72; \
        if (MODE == 2) *(LAS u32x4*)(_vb + lr * 72 + lch * 8) = (r_); \
        else { _Pragma("unroll") for (int _e = 0; _e < 8; ++_e) { const unsigned _w = (r_)[_e >> 1]; _vb[(vch * 8 + _e) * 72 + vkey] = (bf16_t)((_e & 1) ? (_w >> 16) : (_w & 0xffffu)); } } } while (0)
    u32x4 kreg = *(const u32x4*)(Kg + (size_t)(tb * 64 + lr) * 64 + lch * 8);
    u32x4 vreg = FP_LOADV(tb);
    __syncthreads();
    *(LAS u32x4*)(Ks + lr * 72 + lch * 8) = kreg; FP_STOREV(0, vreg);
    __syncthreads();
    for (int tile = tb; tile < te; ++tile) {
        const int buf = (tile - tb) & 1; const bool more = tile + 1 < te;
        if (more) { kreg = *(const u32x4*)(Kg + (size_t)((tile + 1) * 64 + lr) * 64 + lch * 8); vreg = FP_LOADV(tile + 1); }
        const LAS bf16_t* Kb = Ks + buf * 64 * 72; const LAS bf16_t* Vb = Vs + buf * 64 * 72;
        const int key0 = tile * 64;
        bool need[2]; float sinit[2];
#pragma unroll
        for (int qi = 0; qi < 2; ++qi) { bool sel = true; if (MODE == 0) sel = ((sm[qi] >> tile) & 1ull) != 0ull; sinit[qi] = sel ? -SOFF : -1e30f; need[qi] = MODE == 0 ? (__ballot(sel) != 0ull) : true; }
        const bool boundary = MODE == 2 ? true : (MODE == 0 ? (tile == te - 1) : (tile == te - 1 || tile + 8 == te - 1));
        if (need[0] && need[1]) tile_compute<MODE, true, true>(Kb, Vb, qf, tq, sinit, boundary, key0, O, lrow, fr, g4);
        else if (MODE == 0 && need[0]) tile_compute<MODE, true, false>(Kb, Vb, qf, tq, sinit, boundary, key0, O, lrow, fr, g4);
        else if (MODE == 0 && need[1]) tile_compute<MODE, false, true>(Kb, Vb, qf, tq, sinit, boundary, key0, O, lrow, fr, g4);
        if (more) { *(LAS u32x4*)(Ks + (buf ^ 1) * 64 * 72 + lr * 72 + lch * 8) = kreg; FP_STOREV(buf ^ 1, vreg); }
        asm volatile("s_waitcnt lgkmcnt(0)" ::: "memory"); __builtin_amdgcn_s_barrier(); asm volatile("" ::: "memory");
    }
#undef FP_LOADV
#undef FP_STOREV
}

constexpr int CK_OFF = 0, CV_OFF = 36864, CP_OFF = 70656, CV_STR = 264;
__device__ __forceinline__ float dpp_xor1(float x) { return __int_as_float(__builtin_amdgcn_update_dpp(0, __float_as_int(x), 0xB1, 0xf, 0xf, true)); }
__device__ __forceinline__ float dpp_xor2(float x) { return __int_as_float(__builtin_amdgcn_update_dpp(0, __float_as_int(x), 0x4E, 0xf, 0xf, true)); }
__device__ __forceinline__ void cmp_item(const Params& P, int bg, int qt, LAS unsigned char* lds) {
    unsigned char* ws = P.ws; const int tid = opaque_tid(), lane = tid & 63, wave = tid >> 6, fr = lane & 15, g4 = lane >> 4;
    const int b = bg >> 1, g = bg & 1, t0 = qt * 64;
    const bf16_t* Q = (const bf16_t*)(ws + OFF_QN) + (((size_t)bg * 4096 + t0) * 4 + 32 * wave) * 64;
    bf16x8 qf[2][2]; int tq[2];
#pragma unroll
    for (int qi = 0; qi < 2; ++qi) { tq[qi] = t0 + 8 * wave + 4 * qi + (fr >> 2);
#pragma unroll
        for (int ks = 0; ks < 2; ++ks) qf[qi][ks] = *(const bf16x8*)(Q + (size_t)(16 * qi + fr) * 64 + 32 * ks + 8 * g4); }
    const bf16_t* Kc = (const bf16_t*)(ws + OFF_KCN) + (size_t)bg * 256 * 64; const bf16_t* Vc = (const bf16_t*)(ws + OFF_VCT) + (size_t)bg * 64 * 256;
    const int te = ((4 * qt + 2) >> 6) + 1;
    LAS bf16_t* Ka = (LAS bf16_t*)(lds + CK_OFF); LAS bf16_t* Va = (LAS bf16_t*)(lds + CV_OFF); LAS float* Pb = (LAS float*)(lds + CP_OFF);
    { const int lr = tid >> 3, lch = tid & 7;
      __syncthreads();
      for (int tile = 0; tile < te; ++tile) {
          *(LAS u32x4*)(Ka + (tile * 64 + lr) * 72 + lch * 8) = *(const u32x4*)(Kc + (size_t)(tile * 64 + lr) * 64 + lch * 8);
          *(LAS u32x4*)(Va + lr * CV_STR + tile * 64 + lch * 8) = *(const u32x4*)(Vc + (size_t)lr * 256 + tile * 64 + lch * 8); }
      __syncthreads(); }
    f32x4 O[2][4]; float lrow[2] = {0.f, 0.f}; const float sinit[2] = {-SOFF, -SOFF};
#pragma unroll
    for (int qi = 0; qi < 2; ++qi)
#pragma unroll
        for (int dt = 0; dt < 4; ++dt) O[qi][dt] = (f32x4){0.f, 0.f, 0.f, 0.f};
    for (int tile = 0; tile < te; ++tile) tile_compute<2, true, true, CV_STR>(Ka + tile * 64 * 72, Va + tile * 64, qf, tq, sinit, true, tile * 64, O, lrow, fr, g4);
    float linv[2];
#pragma unroll
    for (int qi = 0; qi < 2; ++qi) { float lt = lrow[qi]; lt += __shfl_xor(lt, 16); lt += __shfl_xor(lt, 32); linv[qi] = lt > 0.f ? 1.0f / lt : 0.f; }
    const float* ng = (const float*)(ws + OFF_NGATE);
#pragma unroll
    for (int qi = 0; qi < 2; ++qi) { const int t = tq[qi], r = fr & 3, h = g * 4 + r; const size_t tok = (size_t)b * 4096 + t; const float gc = ng[tok * 24 + h * 3 + 0] * linv[qi];
#pragma unroll
        for (int dt = 0; dt < 4; ++dt) { u32x2 w; w.x = cvt_pk_bf16(O[qi][dt][0] * gc, O[qi][dt][1] * gc); w.y = cvt_pk_bf16(O[qi][dt][2] * gc, O[qi][dt][3] * gc);
            *(u32x2*)((bf16_t*)(ws + OFF_OC) + tok * 512 + h * 64 + 16 * dt + 4 * g4) = w; } }
    for (int tile = 0; tile < te; ++tile) {
        const LAS bf16_t* Kb = Ka + tile * 64 * 72;
#pragma unroll
        for (int kt = 0; kt < 4; ++kt) { f32x4 S0 = (f32x4){-SOFF, -SOFF, -SOFF, -SOFF}, S1 = S0;
#pragma unroll
            for (int ks = 0; ks < 2; ++ks) { const bf16x8 kf = *(const LAS bf16x8*)(Kb + (16 * kt + fr) * 72 + 32 * ks + 8 * g4); S0 = MFMA16(kf, qf[0][ks], S0); S1 = MFMA16(kf, qf[1][ks], S1); }
#pragma unroll
            for (int qi = 0; qi < 2; ++qi) { f32x4 pv;
#pragma unroll
                for (int j = 0; j < 4; ++j) { const int key = tile * 64 + 16 * kt + 4 * g4 + j; const bool valid = (16 * key + 31) <= tq[qi]; const float sv = qi ? S1[j] : S0[j];
                    float p = valid ? fexp2(sv) * linv[qi] : 0.f; p += dpp_xor1(p); p += dpp_xor2(p); pv[j] = p; }
                if ((fr & 3) == 0) *(LAS f32x4*)(Pb + (8 * wave + 4 * qi + (fr >> 2)) * 256 + tile * 64 + 16 * kt + 4 * g4) = pv; }
        }
    }
    __syncthreads();
    for (int rp = 0; rp < (((REP_MASK >> 16) & 1) ? 2 : 1); ++rp)
    for (int tk = 0; tk < 8; ++tk) {
        const int ti = 8 * wave + tk, t = t0 + ti; const LAS float* Pr = Pb + ti * 256; const int nmax = t >= 31 ? ((t - 31) >> 4) : -1; const int j = lane;
        float imp = 0.f;
        { const int n0 = 4 * j;
          if (n0 - 1 >= 0 && n0 - 1 <= nmax) imp += 0.5f * Pr[n0 - 1];
          if (n0 <= nmax) imp += Pr[n0];
          if (n0 + 1 <= nmax) imp += Pr[n0 + 1];
          if (n0 + 2 <= nmax) imp += Pr[n0 + 2];
          if (n0 + 3 <= nmax) imp += 0.5f * Pr[n0 + 3]; }
        const int cur = t >> 6; const bool valid = j <= cur, forced = (j == 0) || (j == cur) || (j == cur - 1);
        unsigned long long mask;
        if (cur < 16) mask = (2ull << cur) - 1ull;
        else {
            const unsigned u = valid ? __float_as_uint(forced ? 1e4f : imp) : 0u;
            unsigned T = 0u;
            for (int bit = 30; bit >= 0; --bit) { const unsigned cand = T | (1u << bit); if (__popcll(__ballot(u >= cand)) >= 16) T = cand; }
            const unsigned long long gt = __ballot(u > T), eq = __ballot(u == T); const int need = 16 - __popcll(gt);
            const int below = __popcll(eq & ((1ull << j) - 1ull));
            mask = gt | __ballot(u == T && below < need);
        }
        if (lane == 0) ((unsigned long long*)(ws + OFF_SELM))[(size_t)bg * 4096 + t] = mask;
    }
    __syncthreads();
}

__device__ __forceinline__ void attn_item(const Params& P, int bg, int qt, LAS unsigned char* lds) {
    unsigned char* ws = P.ws; const int tid = opaque_tid(), lane = tid & 63, wave = tid >> 6, fr = lane & 15, g4 = lane >> 4;
    const int b = bg >> 1, g = bg & 1, t0 = qt * 64;
    const bf16_t* Q = (const bf16_t*)(ws + OFF_QN) + (((size_t)bg * 4096 + t0) * 4 + 32 * wave) * 64;
    bf16x8 qf[2][2]; int tq[2]; unsigned long long sm[2];
#pragma unroll
    for (int qi = 0; qi < 2; ++qi) { tq[qi] = t0 + 8 * wave + 4 * qi + (fr >> 2); sm[qi] = ((const unsigned long long*)(ws + OFF_SELM))[(size_t)bg * 4096 + tq[qi]];
#pragma unroll
        for (int ks = 0; ks < 2; ++ks) qf[qi][ks] = *(const bf16x8*)(Q + (size_t)(16 * qi + fr) * 64 + 32 * ks + 8 * g4); }
    f32x4 O[2][4]; float mrow[2], lrow[2]; LAS f32x4* Rl = (LAS f32x4*)(lds + ATT_P);
    const float* ng = (const float*)(ws + OFF_NGATE);
    for (int pass = 0; pass < 2; ++pass) {
#pragma unroll
        for (int qi = 0; qi < 2; ++qi) { mrow[qi] = -1e30f; lrow[qi] = 0.f;
#pragma unroll
            for (int dt = 0; dt < 4; ++dt) O[qi][dt] = (f32x4){0.f, 0.f, 0.f, 0.f}; }
        if (pass == 0) flash_pass<0>(lds, (const bf16_t*)(ws + OFF_KSEL) + (size_t)bg * 4096 * 64, (const bf16_t*)(ws + OFF_VSELT) + (size_t)bg * 4096 * 64, 64, 0, qt + 1, qf, tq, sm, O, mrow, lrow, tid, lane);
        else flash_pass<1>(lds, (const bf16_t*)(ws + OFF_KWIN) + (size_t)bg * 4096 * 64, (const bf16_t*)(ws + OFF_VWINT) + (size_t)bg * 4096 * 64, 64, qt >= 8 ? qt - 8 : 0, qt + 1, qf, tq, sm, O, mrow, lrow, tid, lane);
#pragma unroll
        for (int qi = 0; qi < 2; ++qi) { float lt = lrow[qi]; lt += __shfl_xor(lt, 16); lt += __shfl_xor(lt, 32); const int h = g * 4 + (fr & 3); const size_t tok = (size_t)b * 4096 + tq[qi];
            const float gsc = ng[tok * 24 + h * 3 + 1 + pass] * (lt > 0.f ? 1.0f / lt : 0.f);
#pragma unroll
            for (int dt = 0; dt < 4; ++dt) { if (pass == 0) Rl[(qi * 4 + dt) * 512 + tid] = O[qi][dt] * gsc; else O[qi][dt] = O[qi][dt] * gsc + Rl[(qi * 4 + dt) * 512 + tid]; } }
    }
    { u32x2 cvv[2][4];
#pragma unroll
      for (int qi = 0; qi < 2; ++qi) { const int h = g * 4 + (fr & 3); const size_t tok = (size_t)b * 4096 + tq[qi];
#pragma unroll
          for (int dt = 0; dt < 4; ++dt) cvv[qi][dt] = *(const u32x2*)((const bf16_t*)(ws + OFF_OC) + tok * 512 + h * 64 + 16 * dt + 4 * g4); }
#pragma unroll
      for (int qi = 0; qi < 2; ++qi) { const int h = g * 4 + (fr & 3); const size_t tok = (size_t)b * 4096 + tq[qi];
#pragma unroll
          for (int dt = 0; dt < 4; ++dt) { const size_t o = tok * 512 + h * 64 + 16 * dt + 4 * g4; const u32x2 cv = cvv[qi][dt];
              const float c0 = __uint_as_float(cv.x << 16), c1 = __uint_as_float(cv.x & 0xffff0000u), c2 = __uint_as_float(cv.y << 16), c3 = __uint_as_float(cv.y & 0xffff0000u);
              u32x2 w; w.x = cvt_pk_bf16(O[qi][dt][0] + c0, O[qi][dt][1] + c1); w.y = cvt_pk_bf16(O[qi][dt][2] + c2, O[qi][dt][3] + c3);
              *(u32x2*)((bf16_t*)(ws + OFF_NSA) + o) = w; } } }
}

#define XB_TMO      128
#define XB_XCNT(j)  (256  + 64 * (j))
#define XB_XSUB(j)  (1280 + 64 * (j))
#define XB_XGEN(j)  (2304 + 64 * (j))
#define XB_TOP      3328
#define XB_TOPGEN   3392
#define XCD_BAR_WORDS 3456
#define XB_SPIN_CAP (1u << 18)
__device__ __forceinline__ unsigned xb_ld(unsigned* p)              { return __hip_atomic_load(p, __ATOMIC_RELAXED, __HIP_MEMORY_SCOPE_AGENT); }
__device__ __forceinline__ unsigned xb_add(unsigned* p, unsigned v) { return __hip_atomic_fetch_add(p, v, __ATOMIC_RELAXED, __HIP_MEMORY_SCOPE_AGENT); }
__device__ __forceinline__ unsigned xb_xcc_id() { return (unsigned)__builtin_amdgcn_s_getreg((3 << 11) | 20) & 0xFu; }
#define XB_SPIN(cond, bar) do { unsigned _sp = 0; while (cond) { __builtin_amdgcn_s_sleep(1); \
    if ((++_sp & 255u) == 0u) { if (xb_ld(&(bar)[XB_TMO])) break; if (_sp > XB_SPIN_CAP) { atomicAdd(&(bar)[XB_TMO], 1u); break; } } } } while (0)
struct XcdBarrier { unsigned* bar; unsigned x; volatile LAS unsigned* st; };
__device__ __forceinline__ XcdBarrier xcd_barrier_post(unsigned* bar, volatile LAS unsigned* st) {
    XcdBarrier b; b.bar = bar; b.x = xb_xcc_id(); b.st = st;
    if (threadIdx.x == 0) (void)xb_add(&bar[XB_XCNT(b.x)], 1u);
    return b;
}
__device__ __forceinline__ void xcd_barrier_complete(unsigned* bar, unsigned x, unsigned& nloc, unsigned& nx) {
    const unsigned G = gridDim.x * gridDim.y * gridDim.z;
    unsigned sum, cnt, mine, sp = 0u;
    for (;;) {
        sum = 0u; cnt = 0u; mine = 0u;
#pragma unroll
        for (unsigned j = 0; j < 16; ++j) { const unsigned c = xb_ld(&bar[XB_XCNT(j)]); sum += c; cnt += (c > 0u) ? 1u : 0u; mine = (j == x) ? c : mine; }
        if (sum == G) break;
        __builtin_amdgcn_s_sleep(1);
        if ((++sp & 255u) == 0u) { if (xb_ld(&bar[XB_TMO])) break; if (sp > XB_SPIN_CAP) { atomicAdd(&bar[XB_TMO], 1u); break; } }
    }
    nloc = mine > 0u ? mine : 1u; nx = cnt > 0u ? cnt : 1u;
}
__device__ __forceinline__ void xcd_barrier(const XcdBarrier& b) {
    asm volatile("s_waitcnt vmcnt(0)" ::: "memory");
    __syncthreads();
    if (threadIdx.x == 0) {
        unsigned* bar = b.bar;
        __builtin_amdgcn_s_waitcnt(0);
        unsigned nloc = b.st[0], nx = b.st[1];
        if (nloc == 0u) { xcd_barrier_complete(bar, b.x, nloc, nx); b.st[0] = nloc; b.st[1] = nx; }
        const unsigned old = xb_add(&bar[XB_XSUB(b.x)], 1u);
        const unsigned gen = old / nloc;
        if (old + 1u == (gen + 1u) * nloc) {
            __builtin_amdgcn_fence(__ATOMIC_RELEASE, "agent");
            asm volatile("s_waitcnt vmcnt(0)" ::: "memory");
            const unsigned og = xb_add(&bar[XB_TOP], 1u);
            const unsigned tg = og / nx;
            if (og + 1u == (tg + 1u) * nx) xb_add(&bar[XB_TOPGEN], 1u);
            else XB_SPIN(xb_ld(&bar[XB_TOPGEN]) == tg, bar);
            __builtin_amdgcn_fence(__ATOMIC_ACQUIRE, "agent");
            xb_add(&bar[XB_XGEN(b.x)], 1u);
            asm volatile("s_waitcnt vmcnt(0)" ::: "memory");
        } else {
            XB_SPIN(xb_ld(&bar[XB_XGEN(b.x)]) == gen, bar);
            __builtin_amdgcn_fence(__ATOMIC_ACQUIRE, "agent");
            asm volatile("s_waitcnt vmcnt(0)" ::: "memory");
        }
    }
    __syncthreads();
}

constexpr int N_INIT = 3, PH_PER_LAYER = 12, N_PHASES = N_INIT + NLAYER * PH_PER_LAYER;
__device__ __forceinline__ Gemm mk_gemm(const void* A, const void* Bt, int lda, int ldb, int K, int nM, int nN) {
    Gemm g; g.A = (const bf16_t*)A; g.Bt = (const bf16_t*)Bt; g.lda = lda; g.ldb = ldb; g.K = K; g.nM = nM; g.nN = nN; g.nZ = 1; g.nZ2 = 1; g.sA1 = g.sA2 = g.sB1 = g.sB2 = 0; return g;
}
#ifndef ONLY
#define ONLY -1
#endif
#define EN(x) (ONLY < 0 || ONLY == (x))
typedef const Params __attribute__((address_space(4)))* KParamsPtr;
__device__ __forceinline__ void run_phase(int ph, LAS unsigned char* lds) {
#if defined(__HIP_DEVICE_COMPILE__)
    unsigned long long kpa = (unsigned long long)__builtin_amdgcn_kernarg_segment_ptr(); asm volatile("" : "+s"(kpa));
    const Params P = *(KParamsPtr)kpa;
#else
    const Params P{};
#endif
    unsigned char* ws = P.ws; const int G = gridDim.x, c = opaque_bid();
    if (ph == 0) { if (EN(100)) phase_init_a(P, lds); return; }
    if (ph == 1) { if (EN(101)) phase_init_b(P, lds); return; }
    if (ph == 2) { if (EN(102)) phase_init_c(P); return; }
    const int l = (ph - N_INIT) / PH_PER_LAYER, sp = (ph - N_INIT) % PH_PER_LAYER;
    float* part = (float*)(ws + OFF_PART); bf16_t* xb = (bf16_t*)(ws + OFF_XB);
    unsigned char* wsw = ws + ((l & 1) ? OFF_WALT : 0);
    const bool ovl = (G == 256); const bool pre = ovl && l + 1 < NLAYER;
    int pj0 = 0, pj1 = 0, pwi = -1, pwn = 1;
    if (sp == 0) { if (!ovl || l == 0) { pj0 = 0; pj1 = 3008; pwi = c; pwn = G; } }
    else if (pre && sp == 1) { pj0 = 0; pj1 = 1024; pwi = c - 128; pwn = 128; }
    else if (pre && sp == 4) { pj0 = 1024; pj1 = 1504; pwi = c - 64; pwn = G - 64; }
    else if (pre && sp == 5) { pj0 = 1504; pj1 = 1984; pwi = c - 96; pwn = G - 96; }
    else if (pre && sp == 10) { pj0 = 1984; pj1 = 3008; pwi = c - 128; pwn = 128; }
    const int pl = sp == 0 ? l : l + 1;
    Sched S;
    switch (sp) {
    case 0: break;
    case 1: case 10: if (EN(1)) {
        Gemm g = mk_gemm(xb, wsw + (sp == 1 ? OFF_WI1 : OFF_WI2), 1024, 1024, 1024, 64, 22); S.init(g, G, c);
        EpiFFNup e; e.part = part; e.G = (bf16_t*)(ws + OFF_G); pg8::gemm_phase(lds, g, S, e); } break;
    case 2: case 11: if (EN(2)) {
        Gemm g = mk_gemm(ws + OFF_G, wsw + (sp == 2 ? OFF_WO1 : OFF_WO2), 2816, 2816, 2816, 64, 4); S.init(g, G, c);
        EpiResid e; e.out = (l == NLAYER - 1 && sp == 11) ? P.out : nullptr; e.xb = xb; e.part = part; e.alpha = ((REP_MASK >> 2) & 1) ? 0.25f : 0.5f; pg8::gemm_phase(lds, g, S, e); } break;
    case 3: if (EN(3)) {
        Gemm g = mk_gemm(xb, wsw + OFF_WIN, 1024, 1024, 1024, 64, 16); S.init(g, G, c);
        EpiWin e; e.q_norm = P.q_norm + l * 64; e.k_norm = P.k_norm + l * 192; e.ws = ws; pg8::gemm_phase(lds, g, S, e); } break;
    case 4: if (EN(4)) {
        if (c < 64 || G < 192) {
            Gemm g = mk_gemm(ws + OFF_AG, ws + OFF_PT + (size_t)l * 32 * 128 * 512 * 2, 640, 512, 512, 2, 1); g.nZ = 32; g.sA1 = 512 * 640; g.sB1 = 128 * 512;
            S.init(g, G < 192 ? G : 64, c); EpiS5A e; e.E = (float*)(ws + OFF_E); pg8::gemm_phase(lds, g, S, e); }
        if (c >= 64 || G < 192) {
            Gemm g = mk_gemm(ws + OFF_KCR, wsw + OFF_CW1, 1024, 2048, 256, 8, 1); g.nZ = 16; g.nZ2 = 8; g.sA1 = (long)((OFF_VCR - OFF_KCR) / 2); g.sA2 = 256; g.sB1 = 256 * 2048; g.sB2 = 256;
            S.init(g, G < 192 ? G : 128, G < 192 ? c : (c < 192 ? c - 64 : -1)); EpiCmp1 e; e.cp = (float*)(ws + OFF_CPART); pg8::gemm_phase(lds, g, S, e); }
        } break;
    case 5: if (EN(5)) phase_p5(P, l, lds); break;
    case 6: if (EN(6)) {
        Gemm g = mk_gemm(ws + OFF_AG, ws + OFF_TQ + (size_t)l * 32 * 512 * 640 * 2, 640, 640, 640, 2, 2); g.nZ = 32; g.sA1 = 512 * 640; g.sB1 = 512 * 640; S.init(g, G, c);
        EpiS5C e; e.y = (bf16_t*)(ws + OFF_Y); pg8::gemm_phase(lds, g, S, e);
        {
            const bool bal = G == 256; const int cnt = bal ? (c < 128 ? 1 : 3) : 512;
            for (int k = 0; k < cnt; ++k) {
                int bg, qt;
                if (bal) { if (c >= 128 && k == 2) { const int ci = c - 128; bg = ci >> 4; qt = ci & 15; }
                           else { const int ei = c < 128 ? c : 128 + 2 * (c - 128) + k; bg = ei / 48; qt = 16 + ei % 48; } }
                else { const int it = c + k * G; if (it >= 512) break; bg = it >> 6; qt = it & 63; }
                cmp_item(P, bg, qt, lds); } } } break;
    case 7: if (EN(7)) {
        for (int rep = 0; rep < (((REP_MASK >> 7) & 1) ? 2 : 1); ++rep)
        for (int it2 = 2 * c; it2 < 512; it2 += ((it2 & 1) ? 2 * G - 1 : 1)) { const int it = it2 >> 1; const int bg = it >> 5, qa = it & 31; attn_item(P, bg, (it2 & 1) ? qa : 63 - qa, lds); }
        __syncthreads();
        Gemm g = mk_gemm(ws + OFF_Y, wsw + OFF_WGLU, 512, 512, 512, 64, 8); S.init(g, G, c);
        EpiGLU e; e.ga = (bf16_t*)(ws + OFF_GA); pg8::gemm_phase(lds, g, S, e); } break;
    case 8: if (EN(8)) {
        Gemm g = mk_gemm(ws + OFF_NSA, wsw + OFF_WUP, 512, 512, 512, 64, 4); S.init(g, G, c);
        EpiUp e; e.mg = (bf16_t*)(ws + OFF_GA); e.gb = (const bf16_t*)(ws + OFF_GB); pg8::gemm_phase(lds, g, S, e); } break;
    case 9: if (EN(9)) {
        Gemm g = mk_gemm(ws + OFF_GA, wsw + OFF_WOUT, 1024, 1024, 1024, 64, 4); S.init(g, G, c);
        EpiResid e; e.out = nullptr; e.xb = xb; e.part = part; e.alpha = ((REP_MASK >> 9) & 1) ? 0.5f : 1.0f; pg8::gemm_phase(lds, g, S, e); } break;
    }
    if (pwi >= 0 && pj1 > pj0) { __syncthreads(); prep_jobs(P, pl, lds, pj0, pj1, pwi, pwn); }
}

__global__ void __launch_bounds__(512) mega(Params P) {
    extern __shared__ __attribute__((aligned(16))) unsigned char lds_raw[];
    LAS unsigned char* lds = (LAS unsigned char*)lds_raw;
    volatile LAS unsigned* st = (volatile LAS unsigned*)(lds + LDS_WORK);
    if (threadIdx.x == 0) { st[0] = 0u; st[1] = 0u; }
    __syncthreads();
    XcdBarrier bar; bar.bar = (unsigned*)(P.ws + OFF_BAR); bar.x = 0; bar.st = st;
    if (P.ph1 - P.ph0 > 1) bar = xcd_barrier_post((unsigned*)(P.ws + OFF_BAR), st);
    for (int ph = P.ph0; ph < P.ph1; ++ph) {
        if (ph >= N_INIT + PH_PER_LAYER && (ph - N_INIT) % PH_PER_LAYER == 0 && gridDim.x == 256 && P.ph1 - P.ph0 > 1) continue;
        int nrep = 1; if (REP_MASK) { const int bit = ph < N_INIT ? 12 + ph : (ph - N_INIT) % PH_PER_LAYER; if (bit != 7 && ((REP_MASK >> bit) & 1)) nrep = 2; }
        for (int r = 0; r < nrep; ++r) { if (r) __syncthreads(); run_phase(ph, lds); }
        if (ph + 1 < P.ph1) {
            if (P.ph0 < 0) { __threadfence(); cg::this_grid().sync(); }
            xcd_barrier(bar); if ((REP_MASK >> 15) & 1) xcd_barrier(bar);
        }
    }
}

extern "C" void kernel_launch(void* const* d_in, const int* in_sizes, int n_in, void* d_out, int out_size, void* d_ws, size_t ws_size, hipStream_t stream) {
    static int grid = 0;
    if (grid == 0) {
        if (n_in != 25 || out_size != NTOK * DM || ws_size < WS_END) { fprintf(stderr, "kernel_launch: unexpected shapes (n_in %d out %d ws %zu need %zu)\n", n_in, out_size, ws_size, (size_t)WS_END); grid = -1; return; }
        int dev = 0, cus = 0, per_cu = 0;
        hipGetDevice(&dev); hipDeviceGetAttribute(&cus, hipDeviceAttributeMultiprocessorCount, dev);
        if (hipFuncSetAttribute((const void*)mega, hipFuncAttributeMaxDynamicSharedMemorySize, LDS_BYTES) != hipSuccess) { fprintf(stderr, "hipFuncSetAttribute failed\n"); grid = -1; return; }
        if (hipOccupancyMaxActiveBlocksPerMultiprocessor(&per_cu, (const void*)mega, 512, LDS_BYTES) != hipSuccess || per_cu < 1) { fprintf(stderr, "occupancy query: %d\n", per_cu); per_cu = 1; }
        (void)hipGetLastError();
        grid = cus * 1;
    }
    if (grid < 0) return;
    Params p{};
    const float** pp = (const float**)&p;
    for (int i = 0; i < 25; ++i) pp[i] = (const float*)d_in[i];
    p.out = (float*)d_out; p.ws = (unsigned char*)d_ws;
    if (hipMemsetAsync((char*)d_ws + OFF_BAR, 0, 16384, stream) != hipSuccess) { fprintf(stderr, "memset failed\n"); return; }
#if MULTI_LAUNCH
    for (int ph = 0; ph < N_PHASES; ++ph) { p.ph0 = ph; p.ph1 = ph + 1; hipLaunchKernelGGL(mega, dim3(grid), dim3(512), LDS_BYTES, stream, p); }
#else
    p.ph0 = 0; p.ph1 = N_PHASES;
    void* args[] = {&p};
    hipError_t e = hipLaunchCooperativeKernel((const void*)mega, dim3(grid), dim3(512), args, LDS_BYTES, stream);
    if (e != hipSuccess) fprintf(stderr, "cooperative launch failed: %s (grid %d)\n", hipGetErrorString(e), grid);
#endif
}
```
